# Optimizing an MI355X kernel written in HIP

```python
import jax, jax.numpy as jnp
from jax import lax
import numpy as np

D_MODEL = 2048
BATCH = 1
SEQ = 8192
DEPTH = 4

CTX_LEN = 256
GRID_W = 64
HEAD_DIM = 128
ATTN_HEADS = D_MODEL // (2 * HEAD_DIM)
ATTN_KV_HEADS = ATTN_HEADS // 4
ATTN_GROUP = ATTN_HEADS // ATTN_KV_HEADS
ATTN_WIDTH = ATTN_HEADS * HEAD_DIM
KV_WIDTH = ATTN_KV_HEADS * HEAD_DIM
HG_DK = 128
HG_DV = 128
HG_HEADS = D_MODEL // (2 * HG_DV)
HG_KWIDTH = HG_HEADS * HG_DK
HG_WIDTH = HG_HEADS * HG_DV
MIX_WIDTH = ATTN_WIDTH + HG_WIDTH
IN_WIDTH = ATTN_WIDTH + 2 * KV_WIDTH + 3 * HG_KWIDTH + 2 * HG_WIDTH
Q_BLOCK = 128
CHUNK = 64
ROPE_THETA = 10000.0
ROPE_FREQS = HEAD_DIM // 4
D_FF = ((8 * D_MODEL // 3 + 255) // 256) * 256
CONV_W = 3
EPS = 1e-6

kernel_name = 'hybrid_gqa_hgrn2_convffn_dit'


def rms_norm(x, w):
    xf = x.astype(jnp.float32)
    y = xf * lax.rsqrt(jnp.mean(xf * xf, axis=-1, keepdims=True) + EPS)
    return (y * w.astype(jnp.float32)).astype(x.dtype)


def modulate(h, shift, scale):
    return h * (1 + scale) + shift


def axial_rope_angles(L):
    rows = L // GRID_W
    row = jnp.repeat(jnp.arange(rows, dtype=jnp.float32), GRID_W)
    col = jnp.tile(jnp.arange(GRID_W, dtype=jnp.float32), rows)
    freqs = ROPE_THETA ** (-jnp.arange(ROPE_FREQS, dtype=jnp.float32) / ROPE_FREQS)
    ang = jnp.stack([row[:, None] * freqs, col[:, None] * freqs], axis=1)
    return jnp.cos(ang), jnp.sin(ang)


def apply_rope(x, cos, sin):
    B, L, H, _ = x.shape
    xs = x.astype(jnp.float32).reshape(B, L, H, 2, 2, ROPE_FREQS)
    x1, x2 = xs[..., 0, :], xs[..., 1, :]
    c = cos[None, :, None]
    s = sin[None, :, None]
    out = jnp.stack([x1 * c - x2 * s, x2 * c + x1 * s], axis=-2)
    return out.reshape(B, L, H, HEAD_DIM).astype(x.dtype)


def gqa_attend(q, k, v):
    s = jnp.einsum('bqgrd,bkgd->bgrqk', q, k).astype(jnp.float32) * (HEAD_DIM ** -0.5)
    p = jax.nn.softmax(s, axis=-1).astype(v.dtype)
    return jnp.einsum('bgrqk,bkgd->bqgrd', p, v)


def blocked_attention(q, k, v):
    B, L = q.shape[0], q.shape[1]
    nb = L // Q_BLOCK
    qb = q.reshape(B, nb, Q_BLOCK, ATTN_KV_HEADS, ATTN_GROUP, HEAD_DIM).swapaxes(0, 1)
    o = lax.map(lambda blk: gqa_attend(blk, k, v), qb)
    return o.swapaxes(0, 1).reshape(B, L, ATTN_WIDTH)


def hgrn2_scan(q, k, v, logf, s0):
    B, L, H, _ = q.shape
    n = L // CHUNK

    def to_chunks(a):
        return a.reshape(B, n, CHUNK, H, a.shape[-1]).transpose(1, 0, 3, 2, 4)

    lower = jnp.tril(jnp.ones((CHUNK, CHUNK), dtype=bool))[:, :, None]

    def step(S, inp):
        qc, kc, vc, gc = inp
        b = jnp.cumsum(gc, axis=2)
        b_last = b[:, :, -1:, :]
        o_inter = jnp.einsum('bhtd,bhdv->bhtv', qc * jnp.exp(b), S)
        diff = b[:, :, :, None, :] - b[:, :, None, :, :]
        decay = jnp.exp(jnp.where(lower, diff, -jnp.inf))
        scores = jnp.einsum('bhtd,bhtsd,bhsd->bhts', qc, decay, kc)
        o = o_inter + jnp.einsum('bhts,bhsv->bhtv', scores, vc)
        S_new = (jnp.exp(b_last[:, :, 0, :, None]) * S
                 + jnp.einsum('bhsd,bhsv->bhdv', kc * jnp.exp(b_last - b), vc))
        return S_new, o

    s_fin, o = lax.scan(step, s0, (to_chunks(q), to_chunks(k), to_chunks(v), to_chunks(logf)))
    return o.transpose(1, 0, 3, 2, 4).reshape(B, L, H, v.shape[-1]), s_fin


def project(h, w_in, q_norm_w, k_norm_w, lb_f, lb_b):
    B, L, _ = h.shape
    p = h @ w_in
    idx = [ATTN_WIDTH, ATTN_WIDTH + KV_WIDTH, ATTN_WIDTH + 2 * KV_WIDTH,
           ATTN_WIDTH + 2 * KV_WIDTH + HG_KWIDTH, ATTN_WIDTH + 2 * KV_WIDTH + 2 * HG_KWIDTH,
           ATTN_WIDTH + 2 * KV_WIDTH + 3 * HG_KWIDTH, ATTN_WIDTH + 2 * KV_WIDTH + 3 * HG_KWIDTH + HG_WIDTH]
    aq, ak, av, hq, hff, hfb, hi, hg = jnp.split(p, idx, axis=-1)
    aq = rms_norm(aq.reshape(B, L, ATTN_HEADS, HEAD_DIM), q_norm_w)
    ak = rms_norm(ak.reshape(B, L, ATTN_KV_HEADS, HEAD_DIM), k_norm_w)
    av = av.reshape(B, L, ATTN_KV_HEADS, HEAD_DIM)
    hq = jax.nn.silu(hq.astype(jnp.float32)).reshape(B, L, HG_HEADS, HG_DK)

    def forget(f, lb):
        fg = lb + (1 - lb) * jax.nn.sigmoid(f.astype(jnp.float32))
        fg = fg.reshape(B, L, HG_HEADS, HG_DK)
        return 1 - fg, jnp.log(fg)

    k_f, g_f = forget(hff, lb_f)
    k_b, g_b = forget(hfb, lb_b)
    hi = hi.astype(jnp.float32).reshape(B, L, HG_HEADS, HG_DV)
    return aq, ak, av, hq, k_f, g_f, k_b, g_b, hi, hg


def bidir_hgrn2(q, k_f, g_f, k_b, g_b, v, s0_f, s0_b):
    flip = lambda a: jnp.flip(a, axis=1)
    o_f, s_f = hgrn2_scan(q, k_f, v, g_f, s0_f)
    o_b, s_b = hgrn2_scan(flip(q), flip(k_b), flip(v), flip(g_b), s0_b)
    return o_f + flip(o_b), s_f, s_b


def hgrn2_output(o, gate, norm_w):
    B, L = o.shape[0], o.shape[1]
    o = rms_norm(o, norm_w).reshape(B, L, HG_WIDTH).astype(gate.dtype)
    return o * jax.nn.silu(gate)


def dwconv3(u, w, b):
    up = jnp.pad(u, ((0, 0), (1, 1), (0, 0)))
    return up[:, :-2] * w[0] + up[:, 1:-1] * w[1] + up[:, 2:] * w[2] + b


def conv_ffn(h, w_up, conv_w, conv_b, w_down):
    gate, up = jnp.split(h @ w_up, 2, axis=-1)
    gate = dwconv3(gate, conv_w, conv_b)
    return (jax.nn.silu(gate) * up) @ w_down


def setup_inputs(seed: int = 0) -> dict:
    key = jax.random.key(seed)
    ks = jax.random.split(key, 20)
    n = jax.random.normal
    f32 = jnp.float32
    return {
        'x': n(ks[0], (BATCH, SEQ, D_MODEL), f32),
        'c': n(ks[1], (BATCH, D_MODEL), f32),
        'ctx': n(ks[2], (BATCH, CTX_LEN, D_MODEL), f32),
        'c_ctx': n(ks[3], (D_MODEL,), f32),
        'w_mod': n(ks[4], (DEPTH, D_MODEL, 6 * D_MODEL), f32) * (0.5 * D_MODEL ** -0.5),
        'b_mod': n(ks[5], (DEPTH, 6 * D_MODEL), f32) * 0.02,
        'norm1_w': 1.0 + 0.1 * n(ks[6], (DEPTH, D_MODEL), f32),
        'norm2_w': 1.0 + 0.1 * n(ks[7], (DEPTH, D_MODEL), f32),
        'w_in': n(ks[8], (DEPTH, D_MODEL, IN_WIDTH), f32) * (D_MODEL ** -0.5),
        'q_norm_w': 1.0 + 0.1 * n(ks[9], (DEPTH, HEAD_DIM), f32),
        'k_norm_w': 1.0 + 0.1 * n(ks[10], (DEPTH, HEAD_DIM), f32),
        'hg_lb_logits': n(ks[11], (2, DEPTH, HG_KWIDTH), f32),
        'hg_norm_w': 1.0 + 0.1 * n(ks[12], (DEPTH, HG_DV), f32),
        'w_out': n(ks[13], (DEPTH, MIX_WIDTH, D_MODEL), f32) * (MIX_WIDTH ** -0.5),
        'w_up': n(ks[14], (DEPTH, D_MODEL, 2 * D_FF), f32) * (D_MODEL ** -0.5),
        'conv_w': n(ks[15], (DEPTH, CONV_W, D_FF), f32) * (CONV_W ** -0.5),
        'conv_b': n(ks[16], (DEPTH, D_FF), f32) * 0.02,
        'w_down': n(ks[17], (DEPTH, D_FF, D_MODEL), f32) * (D_FF ** -0.5),
        'final_norm_w': 1.0 + 0.1 * n(ks[18], (D_MODEL,), f32),
    }


def reference(x, c, ctx, c_ctx, w_mod, b_mod, norm1_w, norm2_w, w_in, q_norm_w, k_norm_w,
              hg_lb_logits, hg_norm_w, w_out, w_up, conv_w, conv_b, w_down, final_norm_w):
    B, L = x.shape[0], x.shape[1]
    Lc = ctx.shape[1]
    cos, sin = axial_rope_angles(L)
    lb_sm = jax.nn.softmax(hg_lb_logits.astype(jnp.float32), axis=1)
    lb_all = jnp.cumsum(lb_sm, axis=1) - lb_sm[:, :1]
    s_c = jax.nn.silu(c)
    s_cc = jax.nn.silu(c_ctx)
    s0 = jnp.zeros((B, HG_HEADS, HG_DK, HG_DV), jnp.float32)

    for l in range(DEPTH):
        last = l == DEPTH - 1
        mod = (s_c @ w_mod[l] + b_mod[l])[:, None, :]
        mod_c = s_cc @ w_mod[l] + b_mod[l]
        sh1, sc1, g1, sh2, sc2, g2 = jnp.split(mod, 6, axis=-1)
        sh1c, sc1c, g1c, sh2c, sc2c, g2c = jnp.split(mod_c, 6, axis=-1)
        lb_f, lb_b = lb_all[0, l], lb_all[1, l]

        hl = modulate(rms_norm(x, norm1_w[l]), sh1, sc1)
        hc = modulate(rms_norm(ctx, norm1_w[l]), sh1c, sc1c)
        aql, akl, avl, hql, kfl, gfl, kbl, gbl, vl, ggl = project(hl, w_in[l], q_norm_w[l], k_norm_w[l], lb_f, lb_b)
        aqc, akc, avc, hqc, kfc, gfc, kbc, gbc, vc, ggc = project(hc, w_in[l], q_norm_w[l], k_norm_w[l], lb_f, lb_b)

        aql = apply_rope(aql, cos, sin)
        akl = apply_rope(akl, cos, sin)
        k_all = jnp.concatenate([akc, akl], axis=1)
        v_all = jnp.concatenate([avc, avl], axis=1)
        attn_l = blocked_attention(aql, k_all, v_all)

        o_c, s_f, s_b = bidir_hgrn2(hqc, kfc, gfc, kbc, gbc, vc, s0, s0)
        o_l, _, _ = bidir_hgrn2(hql, kfl, gfl, kbl, gbl, vl, s_f, s_b)
        hg_l = hgrn2_output(o_l, ggl, hg_norm_w[l])

        x = x + g1 * (jnp.concatenate([attn_l, hg_l], axis=-1) @ w_out[l])
        h2 = modulate(rms_norm(x, norm2_w[l]), sh2, sc2)
        x = x + g2 * conv_ffn(h2, w_up[l], conv_w[l], conv_b[l], w_down[l])

        if not last:
            attn_c = gqa_attend(aqc.reshape(B, Lc, ATTN_KV_HEADS, ATTN_GROUP, HEAD_DIM), akc, avc)
            attn_c = attn_c.reshape(B, Lc, ATTN_WIDTH)
            hg_c = hgrn2_output(o_c, ggc, hg_norm_w[l])
            ctx = ctx + g1c * (jnp.concatenate([attn_c, hg_c], axis=-1) @ w_out[l])
            h2c = modulate(rms_norm(ctx, norm2_w[l]), sh2c, sc2c)
            ctx = ctx + g2c * conv_ffn(h2c, w_up[l], conv_w[l], conv_b[l], w_down[l])

    return rms_norm(x, final_norm_w)
```

```cpp
#include <hip/hip_runtime.h>
#include <cstdio>
#include <cstdint>

#ifndef MK_ONE_LAUNCH
#define MK_ONE_LAUNCH 1
#endif

namespace pg8 {
#define PG8_LAS __attribute__((address_space(3)))
typedef unsigned short bf16_t;
typedef short bf16x8 __attribute__((ext_vector_type(8)));
typedef float f32x4 __attribute__((ext_vector_type(4)));
typedef unsigned u32x4 __attribute__((ext_vector_type(4)));
constexpr int BM = 256, BK = 64, HALF = 128, HTB = HALF * BK * 2, STAGE_BYTES = 8 * HTB, NXCD = 8, WGM = 8;

__host__ __device__ __forceinline__ int lds_byte(int r, int c) { const int st = (r >> 4) * 2 + (c >> 5), rr = r & 15, cc = c & 31, ob = rr * 64 + cc * 2; return st * 1024 + (ob ^ (((ob >> 9) & 1) << 5)); }
__host__ __device__ __forceinline__ void stage_rc(int b, int& R, int& C) { const int st = b / 1024, sb = b % 1024, swz = sb ^ (((sb >> 9) & 1) << 5); R = (st >> 1) * 16 + swz / 64; C = (st & 1) * 32 + (swz % 64) / 2; }
__host__ __device__ __forceinline__ int perm32(int rho) { const int n = rho >> 4, i = rho & 15; return 8 * (i >> 2) + 4 * n + (i & 3); }

struct Unit { int pm, pn, kt0, nkt, part; };
struct Gemm { const bf16_t* A; const bf16_t* Bt; int M, N, K; };

struct StaticOrder {
    int nM, nN, nwg, G, c, nkt, pm0;
    __host__ __device__ void init(int M, int N, int K, int G_, int c_, int pm0_ = 0) { nM = M / BM; nN = N / BM; nwg = nM * nN; G = G_; c = c_; nkt = K / BK; pm0 = pm0_; }
    __host__ __device__ bool next(int i, Unit& u) const { return by_index((long)i * G + c, u); }
    __host__ __device__ bool by_index(long L, Unit& u) const {
        if (L >= nwg) return false;
        int wgid = (int)L; { const int q = nwg / NXCD, r = nwg % NXCD, xcd = wgid % NXCD, off = wgid / NXCD; wgid = (xcd < r ? xcd * (q + 1) : r * (q + 1) + (xcd - r) * q) + off; }
        const int nig = WGM * nN, gid = wgid / nig, fm = gid * WGM, gsz = (nM - fm) < WGM ? (nM - fm) : WGM;
        u.pm = pm0 + fm + ((wgid % nig) % gsz); u.pn = (wgid % nig) / gsz; u.kt0 = 0; u.nkt = nkt; u.part = -1; return true;
    }
    __device__ __forceinline__ void a_ready(const Unit&) const {}
    __device__ __forceinline__ void done(const Unit&) const {}
};

struct ResidOrder {
    int G, c, nkt, nsplit, skt, with_ctx;
    __host__ __device__ void init(int K, int G_, int c_, bool with_ctx_, int nsplit_) { G = G_; c = c_; nkt = K / BK; with_ctx = with_ctx_ ? 1 : 0; nsplit = nsplit_; skt = (K / BK) / nsplit_; }
    __host__ __device__ bool next(int i, Unit& u) const {
        const int L = i * G + c; const bool lat = L < 256; const int j = L - 256;
        if (!lat && (!with_ctx || j >= 8 * nsplit)) return false;
        const int wgid = (L & 7) * 32 + (L >> 3), r64 = wgid & 63;
        u.pm = lat ? 1 + (wgid >> 6) * 8 + (r64 & 7) : 0; u.pn = lat ? (r64 >> 3) : (j & 7); u.part = lat ? -1 : (j >> 3); u.kt0 = lat ? 0 : (j >> 3) * skt; u.nkt = lat ? nkt : skt; return true;
    }
    __device__ __forceinline__ void a_ready(const Unit&) const {}
    __device__ __forceinline__ void done(const Unit&) const {}
};

__device__ __forceinline__ unsigned cvt_pk_bf16(float lo, float hi) { unsigned r; asm volatile("v_cvt_pk_bf16_f32 %0, %1, %2" : "=v"(r) : "v"(lo), "v"(hi)); return r; }
__device__ __forceinline__ float silu_f(float x) { return x * __builtin_amdgcn_rcpf(1.f + __expf(-x)); }


struct EpiInProj {
    static constexpr bool PERM = true;
    bf16_t* QA; bf16_t* KA; bf16_t* VA; float* PH; const float* qw; const float* kw;
    __device__ __forceinline__ void operator()(const f32x4 (&acc)[2][2][4][2], const Unit& u, int wr, int wc, int fr, int fq, PG8_LAS unsigned char* ldsx) const {
        const int row0 = u.pm * BM + wr * 64 + fr; const int pn = u.pn;
        if (pn >= 6) {
            const int colb = (pn - 6) * 256 + wc * 32 + 8 * fq; const bool act = pn < 10;
#pragma unroll
            for (int ai = 0; ai < 2; ++ai)
#pragma unroll
                for (int m = 0; m < 4; ++m) { float* rowp = PH + (size_t)(row0 + ai * HALF + m * 16) * 5120 + colb;
#pragma unroll
                    for (int bj = 0; bj < 2; ++bj) { f32x4 v0 = acc[ai][bj][m][0], v1 = acc[ai][bj][m][1];
                        if (act) { v0 = (f32x4){silu_f(v0[0]), silu_f(v0[1]), silu_f(v0[2]), silu_f(v0[3])}; v1 = (f32x4){silu_f(v1[0]), silu_f(v1[1]), silu_f(v1[2]), silu_f(v1[3])}; }
                        *(f32x4*)(rowp + bj * HALF) = v0; *(f32x4*)(rowp + bj * HALF + 4) = v1; } }
        } else if (pn == 5) {
            const int colb = wc * 32 + 8 * fq;
#pragma unroll
            for (int ai = 0; ai < 2; ++ai)
#pragma unroll
                for (int m = 0; m < 4; ++m) { bf16_t* rowp = VA + (size_t)(row0 + ai * HALF + m * 16) * 256 + colb;
#pragma unroll
                    for (int bj = 0; bj < 2; ++bj) { const f32x4 v0 = acc[ai][bj][m][0], v1 = acc[ai][bj][m][1]; u32x4 w;
                        w.x = cvt_pk_bf16(v0[0], v0[1]); w.y = cvt_pk_bf16(v0[2], v0[3]); w.z = cvt_pk_bf16(v1[0], v1[1]); w.w = cvt_pk_bf16(v1[2], v1[3]);
                        *(u32x4*)(rowp + bj * HALF) = w; } }
        } else {
            PG8_LAS float* P = (PG8_LAS float*)ldsx;
#pragma unroll
            for (int ai = 0; ai < 2; ++ai)
#pragma unroll
                for (int m = 0; m < 4; ++m)
#pragma unroll
                    for (int bj = 0; bj < 2; ++bj) { const f32x4 a = acc[ai][bj][m][0], b = acc[ai][bj][m][1];
                        float s = (a[0] * a[0] + a[1] * a[1]) + (a[2] * a[2] + a[3] * a[3]) + (b[0] * b[0] + b[1] * b[1]) + (b[2] * b[2] + b[3] * b[3]);
                        s += __shfl_xor(s, 16); s += __shfl_xor(s, 32);
                        if (fq == 0) P[((ai * HALF + wr * 64 + m * 16 + fr) * 2 + bj) * 4 + wc] = s; }
            asm volatile("s_waitcnt lgkmcnt(0)" ::: "memory"); __builtin_amdgcn_s_barrier(); asm volatile("" ::: "memory");
            const bool isq = pn < 4; const float* nw = isq ? qw : kw;
            const int dbase = (wc >> 1) * 64 + (wc & 1) * 16 + fq * 4;
            const f32x4 w0 = *(const f32x4*)(nw + dbase), w1 = *(const f32x4*)(nw + dbase + 32);
            float fr4[4];
#pragma unroll
            for (int e = 0; e < 4; ++e) fr4[e] = exp2f(-(float)((wc & 1) * 16 + fq * 4 + e) * (13.287712379549449f / 32.f));
            const bool rope = u.pm > 0;
#pragma unroll
            for (int ai = 0; ai < 2; ++ai)
#pragma unroll
                for (int m = 0; m < 4; ++m) { const int grow = row0 + ai * HALF + m * 16; const int t = grow - 256; const float pos = (float)((wc >> 1) ? (t & 63) : (t >> 6));
                    f32x4 cs, sn;
#pragma unroll
                    for (int e = 0; e < 4; ++e) { const float ang = pos * fr4[e]; cs[e] = rope ? __cosf(ang) : 1.f; sn[e] = rope ? __sinf(ang) : 0.f; }
#pragma unroll
                    for (int bj = 0; bj < 2; ++bj) { const f32x4 p = *(const PG8_LAS f32x4*)(P + ((ai * HALF + wr * 64 + m * 16 + fr) * 2 + bj) * 4);
                        const float rstd = rsqrtf(((p[0] + p[1]) + (p[2] + p[3])) * (1.f / 128.f) + 1e-6f) * (isq ? 0.12751743074602468f : 1.f);
                        const f32x4 x1 = acc[ai][bj][m][0] * rstd * w0, x2 = acc[ai][bj][m][1] * rstd * w1;
                        const f32x4 o1 = x1 * cs - x2 * sn, o2 = x2 * cs + x1 * sn; u32x4 w;
                        w.x = cvt_pk_bf16(o1[0], o1[1]); w.y = cvt_pk_bf16(o1[2], o1[3]); w.z = cvt_pk_bf16(o2[0], o2[1]); w.w = cvt_pk_bf16(o2[2], o2[3]);
                        bf16_t* dst = isq ? QA + (size_t)grow * 1024 + (2 * pn + bj) * 128 + wc * 32 + 8 * fq : KA + (size_t)grow * 256 + bj * 128 + wc * 32 + 8 * fq;
                        *(u32x4*)dst = w; } }
        }
    }
};
struct EpiResid {
    static constexpr bool PERM = false;
    float* X; const float* Xin; const float* gl; float* PART;
    __device__ __forceinline__ void operator()(const f32x4 (&acc)[2][2][4][2], const Unit& u, int wr, int wc, int fr, int fq, PG8_LAS unsigned char*) const {
        const int row0 = u.pm * BM + wr * 64 + fr, col0 = u.pn * BM + wc * 32 + 4 * fq; const float* g = gl;
        if (u.part >= 0) {
#pragma unroll
            for (int ai = 0; ai < 2; ++ai)
#pragma unroll
                for (int m = 0; m < 4; ++m) { float* rowp = PART + ((size_t)u.part * 256 + (wr * 64 + fr + ai * HALF + m * 16)) * 2048 + col0;
#pragma unroll
                    for (int bj = 0; bj < 2; ++bj)
#pragma unroll
                        for (int n = 0; n < 2; ++n) *(f32x4*)(rowp + bj * HALF + n * 16) = acc[ai][bj][m][n]; }
            return;
        }
        f32x4 gv[2][2];
#pragma unroll
        for (int bj = 0; bj < 2; ++bj)
#pragma unroll
            for (int n = 0; n < 2; ++n) gv[bj][n] = *(const f32x4*)(g + col0 + bj * HALF + n * 16);
#pragma unroll
        for (int ai = 0; ai < 2; ++ai)
#pragma unroll
            for (int m = 0; m < 4; ++m) { float* rowp = X + (size_t)(row0 + ai * HALF + m * 16) * 2048 + col0; const float* rinp = Xin + (size_t)(row0 + ai * HALF + m * 16) * 2048 + col0;
#pragma unroll
                for (int bj = 0; bj < 2; ++bj)
#pragma unroll
                    for (int n = 0; n < 2; ++n) { f32x4* p = (f32x4*)(rowp + bj * HALF + n * 16); *p = *(const f32x4*)(rinp + bj * HALF + n * 16) + gv[bj][n] * acc[ai][bj][m][n]; } }
    }
};
template <int CTRL> __device__ __forceinline__ float dppf(float v) { return __int_as_float(__builtin_amdgcn_update_dpp(0, __float_as_int(v), CTRL, 0xf, 0xf, false)); }
struct EpiUpConv {
    static constexpr bool PERM = true;
    bf16_t* ACT; float* HALO; const float* cw; const float* cb;
    __device__ __forceinline__ void operator()(const f32x4 (&acc)[2][2][4][2], const Unit& u, int wr, int wc, int fr, int fq, PG8_LAS unsigned char* ldsx) const {
        PG8_LAS float* EDGE = (PG8_LAS float*)ldsx;
        const int cg = wc * 32 + 8 * fq, ff = u.pn * 128 + cg;
        if (fr == 0) {
#pragma unroll
            for (int ai = 0; ai < 2; ++ai)
#pragma unroll
                for (int n = 0; n < 2; ++n) *(PG8_LAS f32x4*)(EDGE + ((2 * ai + wr) * 2 + 0) * 128 + cg + 4 * n) = acc[ai][0][0][n]; }
        if (fr == 15) {
#pragma unroll
            for (int ai = 0; ai < 2; ++ai)
#pragma unroll
                for (int n = 0; n < 2; ++n) *(PG8_LAS f32x4*)(EDGE + ((2 * ai + wr) * 2 + 1) * 128 + cg + 4 * n) = acc[ai][0][3][n]; }
        f32x4 w0[2], w1[2], w2[2], bb[2];
#pragma unroll
        for (int n = 0; n < 2; ++n) { w0[n] = *(const f32x4*)(cw + ff + 4 * n); w1[n] = *(const f32x4*)(cw + 5632 + ff + 4 * n); w2[n] = *(const f32x4*)(cw + 2 * 5632 + ff + 4 * n); bb[n] = *(const f32x4*)(cb + ff + 4 * n); }
        asm volatile("s_waitcnt lgkmcnt(0)" ::: "memory"); __builtin_amdgcn_s_barrier(); asm volatile("" ::: "memory");
        float* hb = HALO + (size_t)u.pm * 6 * 5632 + ff;
#pragma unroll
        for (int ai = 0; ai < 2; ++ai) {
            const int chunk = 2 * ai + wr;
            f32x4 ep[2], en[2];
#pragma unroll
            for (int n = 0; n < 2; ++n) {
                ep[n] = (chunk > 0) ? *(const PG8_LAS f32x4*)(EDGE + ((chunk - 1) * 2 + 1) * 128 + cg + 4 * n) : (f32x4){0.f, 0.f, 0.f, 0.f};
                en[n] = (chunk < 3) ? *(const PG8_LAS f32x4*)(EDGE + ((chunk + 1) * 2 + 0) * 128 + cg + 4 * n) : (f32x4){0.f, 0.f, 0.f, 0.f}; }
#pragma unroll
            for (int m = 0; m < 4; ++m) {
                const int row = u.pm * BM + ai * HALF + wr * 64 + m * 16 + fr;
                u32x4 w;
#pragma unroll
                for (int n = 0; n < 2; ++n) {
                    const f32x4 g = acc[ai][0][m][n], up = acc[ai][1][m][n]; f32x4 a;
#pragma unroll
                    for (int e = 0; e < 4; ++e) {
                        float gp = dppf<0x111>(g[e]);
                        if (m > 0) gp += dppf<0x10F>(acc[ai][0][m > 0 ? m - 1 : 0][n][e]);
                        else gp += (fr == 0) ? ep[n][e] : 0.f;
                        float gn = dppf<0x101>(g[e]);
                        if (m < 3) gn += dppf<0x11F>(acc[ai][0][m < 3 ? m + 1 : 3][n][e]);
                        else gn += (fr == 15) ? en[n][e] : 0.f;
                        const float z = w0[n][e] * gp + w1[n][e] * g[e] + w2[n][e] * gn + bb[n][e];
                        a[e] = silu_f(z) * up[e];
                    }
                    if (n == 0) { w.x = cvt_pk_bf16(a[0], a[1]); w.y = cvt_pk_bf16(a[2], a[3]); } else { w.z = cvt_pk_bf16(a[0], a[1]); w.w = cvt_pk_bf16(a[2], a[3]); }
                    if (chunk == 0 && m == 0 && fr < 2) { *(f32x4*)(hb + (size_t)fr * 5632 + 4 * n) = g; if (fr == 0) *(f32x4*)(hb + (size_t)4 * 5632 + 4 * n) = up; }
                    if (chunk == 3 && m == 3 && fr >= 14) { *(f32x4*)(hb + (size_t)(fr - 12) * 5632 + 4 * n) = g; if (fr == 15) *(f32x4*)(hb + (size_t)5 * 5632 + 4 * n) = up; }
                }
                *(u32x4*)(ACT + (size_t)row * 5632 + ff) = w;
            }
        }
    }
};
struct EpiF32 {
    static constexpr bool PERM = false;
    float* O; int ldc;
    __device__ __forceinline__ void operator()(const f32x4 (&acc)[2][2][4][2], const Unit& u, int wr, int wc, int fr, int fq, PG8_LAS unsigned char*) const {
        const int row0 = u.pm * BM + wr * 64 + fr, col0 = u.pn * BM + wc * 32 + 4 * fq;
#pragma unroll
        for (int ai = 0; ai < 2; ++ai)
#pragma unroll
            for (int m = 0; m < 4; ++m) { float* rowp = O + (size_t)(row0 + ai * HALF + m * 16) * ldc + col0;
#pragma unroll
                for (int bj = 0; bj < 2; ++bj)
#pragma unroll
                    for (int n = 0; n < 2; ++n) *(f32x4*)(rowp + bj * HALF + n * 16) = acc[ai][bj][m][n]; }
    }
};

template <class Epi, class Sched>
__device__ __forceinline__ void gemm_phase(PG8_LAS unsigned char* lds, PG8_LAS unsigned char* ldsx, const Gemm g, const Sched& S, const Epi& E) {
    int tid = threadIdx.x; asm volatile("" : "+v"(tid));
    const int wid = __builtin_amdgcn_readfirstlane(tid >> 6), lane = tid & 63, wr = wid >> 2, wc = wid & 3, fr = lane & 15, fq = lane >> 4;
    const int K = g.K;
    unsigned voffA[2], voffB[2];
#pragma unroll
    for (int i = 0; i < 2; ++i) { int R, C; stage_rc(tid * 16 + i * 8192, R, C); const int Rb = Epi::PERM ? ((R & ~31) + perm32(R & 31)) : R;
        voffA[i] = (unsigned)(R * K + C) * 2u; voffB[i] = (unsigned)(Rb * K + C) * 2u; }
    const size_t kstep = (size_t)(BK * 2);
    const size_t hstep = (size_t)HALF * K * 2;
    const size_t tstep = 2 * hstep;
    const unsigned ldsw = (unsigned)wid * 1024u;
    const int aoff = lds_byte(wr * 64 + fr, fq * 8), boff = lds_byte(wc * 32 + fr, fq * 8);
#define PG8_SA(b, h) (((b) * 2 + (h)) * HTB)
#define PG8_SB(b, h) ((4 + (b) * 2 + (h)) * HTB)
#define PG8_STAGE(bufoff, gbase, voff) do { _Pragma("unroll") for (int _i = 0; _i < 2; ++_i) \
        __builtin_amdgcn_global_load_lds((const unsigned*)((const char*)(gbase) + (voff)[_i]), (PG8_LAS unsigned*)(lds + (bufoff) + ldsw + _i * 8192), 16, 0, 0); } while (0)
#define PG8_LDA(dst, b, h) do { _Pragma("unroll") for (int m = 0; m < 4; ++m) _Pragma("unroll") for (int k = 0; k < 2; ++k) dst[m][k] = *(const PG8_LAS bf16x8*)(lds + PG8_SA(b, h) + aoff + m * 2048 + k * 1024); } while (0)
#define PG8_LDB(dst, b, h) do { _Pragma("unroll") for (int n = 0; n < 2; ++n) _Pragma("unroll") for (int k = 0; k < 2; ++k) dst[n][k] = *(const PG8_LAS bf16x8*)(lds + PG8_SB(b, h) + boff + n * 2048 + k * 1024); } while (0)
#define PG8_MMA(ai, bj, At, Bt) do { __builtin_amdgcn_s_setprio(1); _Pragma("unroll") for (int m = 0; m < 4; ++m) _Pragma("unroll") for (int n = 0; n < 2; ++n) _Pragma("unroll") for (int k = 0; k < 2; ++k) \
        acc[ai][bj][m][n] = __builtin_amdgcn_mfma_f32_16x16x32_bf16(Bt[n][k], At[m][k], acc[ai][bj][m][n], 0, 0, 0); __builtin_amdgcn_s_setprio(0); } while (0)
#define PG8_WAIT_V(n) asm volatile("s_waitcnt vmcnt(" #n ")" ::: "memory")
#define PG8_WAIT_L(n) asm volatile("s_waitcnt lgkmcnt(" #n ")" ::: "memory")
#define PG8_BAR __builtin_amdgcn_s_barrier()
#define PG8_SCHED __builtin_amdgcn_sched_barrier(0)
    Unit cur, nxt; int ui = 0;
    if (!S.next(0, cur)) return;
    f32x4 acc[2][2][4][2];
#pragma unroll
    for (int a = 0; a < 2; ++a)
#pragma unroll
        for (int b = 0; b < 2; ++b)
#pragma unroll
            for (int m = 0; m < 4; ++m)
#pragma unroll
                for (int n = 0; n < 2; ++n) acc[a][b][m][n] = (f32x4){0.f, 0.f, 0.f, 0.f};
    bf16x8 At[4][2], B0[2][2], B1[2][2];
    const char* cA = (const char*)g.A + (size_t)cur.pm * tstep + (size_t)cur.kt0 * kstep; const char* cB = (const char*)g.Bt + (size_t)cur.pn * tstep + (size_t)cur.kt0 * kstep;
    S.a_ready(cur);
    PG8_STAGE(PG8_SB(0, 0), cB, voffB); PG8_STAGE(PG8_SB(0, 1), cB + hstep, voffB); PG8_STAGE(PG8_SA(0, 0), cA, voffA); PG8_STAGE(PG8_SA(0, 1), cA + hstep, voffA);
    if (wr == 1) PG8_BAR;
    PG8_WAIT_V(2); PG8_BAR;
    PG8_STAGE(PG8_SB(1, 0), cB + kstep, voffB); PG8_STAGE(PG8_SA(1, 0), cA + kstep, voffA); PG8_STAGE(PG8_SB(1, 1), cB + hstep + kstep, voffB);
    PG8_WAIT_V(6); PG8_BAR;
    for (;;) {
        const bool has_next = S.next(ui + 1, nxt);
        const char* nA = has_next ? (const char*)g.A + (size_t)nxt.pm * tstep + (size_t)nxt.kt0 * kstep : cA; const char* nB = has_next ? (const char*)g.Bt + (size_t)nxt.pn * tstep + (size_t)nxt.kt0 * kstep : cB;
        const int nt = cur.nkt;
        for (int t = 0; t < nt; t += 2) {
            const bool last = (t == nt - 2);
            const char* a1 = cA + (size_t)(t + 1) * kstep;
            const char* a2 = last ? nA : cA + (size_t)(t + 2) * kstep; const char* b2 = last ? nB : cB + (size_t)(t + 2) * kstep;
            const char* a3 = a2 + kstep; const char* b3 = b2 + kstep;
            if (last && has_next) S.a_ready(nxt);
            PG8_LDB(B0, 0, 0); PG8_LDB(B1, 0, 1); PG8_SCHED; PG8_LDA(At, 0, 0); PG8_STAGE(PG8_SA(1, 1), a1 + hstep, voffA);
            PG8_WAIT_V(8); PG8_WAIT_L(0); PG8_BAR; PG8_MMA(0, 0, At, B0); PG8_MMA(0, 1, At, B1); PG8_BAR; PG8_SCHED;
            PG8_LDA(At, 0, 1); PG8_STAGE(PG8_SB(0, 0), b2, voffB); PG8_STAGE(PG8_SB(0, 1), b2 + hstep, voffB); PG8_STAGE(PG8_SA(0, 0), a2, voffA);
            PG8_WAIT_V(8); PG8_WAIT_L(0); PG8_BAR; PG8_MMA(1, 0, At, B0); PG8_MMA(1, 1, At, B1); PG8_BAR; PG8_SCHED;
            PG8_LDB(B0, 1, 0); PG8_LDB(B1, 1, 1); PG8_SCHED; PG8_LDA(At, 1, 0); PG8_STAGE(PG8_SA(0, 1), a2 + hstep, voffA);
            PG8_WAIT_V(8); PG8_WAIT_L(0); PG8_BAR; PG8_MMA(0, 0, At, B0); PG8_MMA(0, 1, At, B1); PG8_BAR; PG8_SCHED;
            PG8_LDA(At, 1, 1); PG8_STAGE(PG8_SB(1, 0), b3, voffB); PG8_STAGE(PG8_SB(1, 1), b3 + hstep, voffB); PG8_STAGE(PG8_SA(1, 0), a3, voffA);
            PG8_WAIT_V(8); PG8_WAIT_L(0); PG8_BAR; PG8_MMA(1, 0, At, B0); PG8_MMA(1, 1, At, B1); PG8_BAR; PG8_SCHED;
        }
        if (wr == 0) PG8_BAR;
        E(acc, cur, wr, wc, fr, fq, ldsx); S.done(cur);
        if (!has_next) break;
#pragma unroll
        for (int a = 0; a < 2; ++a)
#pragma unroll
            for (int b = 0; b < 2; ++b)
#pragma unroll
                for (int m = 0; m < 4; ++m)
#pragma unroll
                    for (int n = 0; n < 2; ++n) acc[a][b][m][n] = (f32x4){0.f, 0.f, 0.f, 0.f};
        cur = nxt; cA = nA; cB = nB; ++ui;
        if (wr == 1) PG8_BAR;
    }
    PG8_WAIT_V(0);
    PG8_BAR;
#undef PG8_SA
#undef PG8_SB
#undef PG8_STAGE
#undef PG8_LDA
#undef PG8_LDB
#undef PG8_MMA
#undef PG8_WAIT_V
#undef PG8_WAIT_L
#undef PG8_BAR
#undef PG8_SCHED
}
}

namespace att {
typedef unsigned short bf16;
using bf16x8 = __attribute__((ext_vector_type(8))) short;
using s16x4  = __attribute__((ext_vector_type(4))) short;
using f32x16 = __attribute__((ext_vector_type(16))) float;
using u32x4  = __attribute__((ext_vector_type(4))) unsigned;
constexpr int   D = 128, NW = 8, QBLK = 32, KVBLK = 64;
constexpr float SCALE = 0.088388347648318440f;
constexpr float THR = 8.f;
constexpr int SDEPTH = 1;
constexpr int LDQ = 1024, LDK = 256, LDO = 2048;
constexpr size_t SHM_V = KVBLK * D * 2, SHM_K = KVBLK * D * 2, SHM_ATTN = 2 * SHM_V + 2 * SHM_K + NW * 64 * 4;
#define KSWZ(row, colB) ((row) * 256 + ((colB) ^ (((row) & 7) << 4)))
#define SBAR() __builtin_amdgcn_sched_barrier(0)
__device__ __forceinline__ int crow(int r, int hi) { return (r & 3) + 8 * (r >> 2) + 4 * hi; }
__device__ __forceinline__ unsigned cvtpk(float lo, float hi) { unsigned r; asm volatile("v_cvt_pk_bf16_f32 %0, %1, %2" : "=v"(r) : "v"(lo), "v"(hi)); return r; }
__device__ __forceinline__ void partialSM(f32x16& p0, f32x16& p1) {
  for (int r = 0; r < 16; ++r) p0[r] = __builtin_amdgcn_exp2f(p0[r]);
}
__device__ __forceinline__ void finishSM(f32x16& p0, f32x16& p1, float& l_reg, bf16x8& pa0, bf16x8& pa1, bf16x8& pa2, bf16x8& pa3) {
  for (int r = 0; r < 16; ++r) p1[r] = __builtin_amdgcn_exp2f(p1[r]);
  float ps = 0; for (int r = 0; r < 16; ++r) ps += p0[r]; for (int r = 0; r < 16; ++r) ps += p1[r];
  { auto rr = __builtin_amdgcn_permlane32_swap(__float_as_uint(ps), __float_as_uint(ps), false, false);
    ps = __uint_as_float(rr[0]) + __uint_as_float(rr[1]); }
  l_reg += ps;
#define PK4(P, BASE, OUT) do { unsigned a0 = cvtpk(P[BASE + 0], P[BASE + 1]), a1 = cvtpk(P[BASE + 2], P[BASE + 3]);   \
    unsigned b0 = cvtpk(P[BASE + 4], P[BASE + 5]), b1 = cvtpk(P[BASE + 6], P[BASE + 7]);                              \
    auto r0 = __builtin_amdgcn_permlane32_swap(a0, b0, false, false); auto r1 = __builtin_amdgcn_permlane32_swap(a1, b1, false, false); \
    u32x4 w = {r0[0], r1[0], r0[1], r1[1]}; OUT = *reinterpret_cast<bf16x8*>(&w); } while (0)
  PK4(p0, 0, pa0); PK4(p0, 8, pa1); PK4(p1, 0, pa2); PK4(p1, 8, pa3);
#undef PK4
}
__device__ __forceinline__ void qkt(f32x16& p0, f32x16& p1, const bf16* Ks, const bf16x8* qr, int r32, int hi) {
  p0 = f32x16{}; p1 = f32x16{};
  for (int d0 = 0; d0 < 8; ++d0) { int cb = (d0 * 16 + hi * 8) * 2;
    bf16x8 b0 = *reinterpret_cast<const bf16x8*>((const char*)Ks + KSWZ(r32, cb));
    bf16x8 b1 = *reinterpret_cast<const bf16x8*>((const char*)Ks + KSWZ(32 + r32, cb));
    p0 = __builtin_amdgcn_mfma_f32_32x32x16_bf16(b0, qr[d0], p0, 0, 0, 0);
    p1 = __builtin_amdgcn_mfma_f32_32x32x16_bf16(b1, qr[d0], p1, 0, 0, 0); }
}
__device__ __forceinline__ int v_st(int k, int c) { const int kk = (k & ~0xC) | ((k & 4) << 1) | ((k & 8) >> 1); return ((kk >> 3) * 4 + (c >> 5)) * 512 + ((kk & 7) * 32 + (c & 31)) * 2; }
__device__ __forceinline__ int v_rd_base(int lane) { return ((lane & 3) << 3) | (((lane >> 2) & 3) << 6) | (((lane >> 4) & 1) << 5) | (((lane >> 5) & 1) << 8); }
constexpr int v_rd_off(int d0, int ks, int half) { return d0 * 512 + ks * 4096 + half * 2048; }
template <int OFF> __device__ __forceinline__ s16x4 tr_read(int vb) {
  s16x4 r; asm volatile("ds_read_b64_tr_b16 %0, %1 offset:%2" : "=&v"(r) : "v"(vb), "i"(OFF) : "memory"); return r;
}
template <int D0> __device__ __forceinline__ void pv_one(f32x16& od, int vb, bf16x8 pa0, bf16x8 pa1, bf16x8 pa2, bf16x8 pa3) {
  const s16x4 l0 = tr_read<v_rd_off(D0, 0, 0)>(vb), h0 = tr_read<v_rd_off(D0, 0, 1)>(vb), l1 = tr_read<v_rd_off(D0, 1, 0)>(vb), h1 = tr_read<v_rd_off(D0, 1, 1)>(vb);
  const s16x4 l2 = tr_read<v_rd_off(D0, 2, 0)>(vb), h2 = tr_read<v_rd_off(D0, 2, 1)>(vb), l3 = tr_read<v_rd_off(D0, 3, 0)>(vb), h3 = tr_read<v_rd_off(D0, 3, 1)>(vb);
  asm volatile("s_waitcnt lgkmcnt(0)" ::: "memory"); SBAR();
#define PK(L, H) (bf16x8){L[0], L[1], L[2], L[3], H[0], H[1], H[2], H[3]}
  od = __builtin_amdgcn_mfma_f32_32x32x16_bf16(pa0, PK(l0, h0), od, 0, 0, 0);
  od = __builtin_amdgcn_mfma_f32_32x32x16_bf16(pa1, PK(l1, h1), od, 0, 0, 0);
  od = __builtin_amdgcn_mfma_f32_32x32x16_bf16(pa2, PK(l2, h2), od, 0, 0, 0);
  od = __builtin_amdgcn_mfma_f32_32x32x16_bf16(pa3, PK(l3, h3), od, 0, 0, 0);
#undef PK
}
__device__ __forceinline__ void pv_d0(f32x16* o, int vb, bf16x8 pa0, bf16x8 pa1, bf16x8 pa2, bf16x8 pa3) {
  pv_one<0>(o[0], vb, pa0, pa1, pa2, pa3); pv_one<1>(o[1], vb, pa0, pa1, pa2, pa3); pv_one<2>(o[2], vb, pa0, pa1, pa2, pa3); pv_one<3>(o[3], vb, pa0, pa1, pa2, pa3);
}
__device__ __forceinline__ void attn_dense_body(const bf16* __restrict__ Qb, const bf16* __restrict__ Kh, const bf16* __restrict__ Vh, bf16* __restrict__ Ob, int seq, char* lds) {
  int tid = threadIdx.x; asm volatile("" : "+v"(tid));
  const int wid = tid >> 6, lane = tid & 63, r32 = lane & 31, hi = lane >> 5;
  bf16* V_lds = (bf16*)lds; bf16* K_lds = (bf16*)(lds + 2 * SHM_V);
  float* ws = (float*)(lds + 2 * SHM_V + 2 * SHM_K) + wid * 64; float* li_l = ws;
  float l_reg = 0; f32x16 o[4] = {}; bf16x8 qr[8];
  const bf16* Qw = Qb + (long)(wid * QBLK + r32) * LDQ + hi * 8;
#pragma unroll
  for (int d0 = 0; d0 < 8; ++d0) qr[d0] = *reinterpret_cast<const bf16x8*>(Qw + d0 * 16);
  const int sr = tid >> 4, sc = (tid & 15) * 8, vst0 = v_st(sr, sc), vst1 = v_st(32 + sr, sc);
  const int vb0 = (int)(uintptr_t)V_lds + v_rd_base(lane);
  struct { bf16x8 vs0, vs1, ks0, ks1; } sr_[SDEPTH];
#define SLOAD(i, k0) do { sr_[i].vs0 = *reinterpret_cast<const bf16x8*>(&Vh[(long)((k0) + sr) * LDK + sc]); sr_[i].vs1 = *reinterpret_cast<const bf16x8*>(&Vh[(long)((k0) + 32 + sr) * LDK + sc]); \
    sr_[i].ks0 = *reinterpret_cast<const bf16x8*>(&Kh[(long)((k0) + sr) * LDK + sc]); sr_[i].ks1 = *reinterpret_cast<const bf16x8*>(&Kh[(long)((k0) + 32 + sr) * LDK + sc]); } while (0)
#define SWRITE(b, i) do { *(bf16x8*)((char*)V_lds + (b) * SHM_V + vst0) = sr_[i].vs0;          \
    *(bf16x8*)((char*)V_lds + (b) * SHM_V + vst1) = sr_[i].vs1; int kc = sc * 2;               \
    *(bf16x8*)((char*)K_lds + (b) * SHM_K + KSWZ(sr, kc)) = sr_[i].ks0;                       \
    *(bf16x8*)((char*)K_lds + (b) * SHM_K + KSWZ(32 + sr, kc)) = sr_[i].ks1; } while (0)
#define SWAIT() do { if constexpr (SDEPTH == 2) asm volatile("s_waitcnt vmcnt(4)" ::: "memory"); else asm volatile("s_waitcnt vmcnt(0)" ::: "memory"); } while (0)
  f32x16 pA0, pA1, pB0, pB1; bf16x8 pa0, pa1, pa2, pa3; const int NT = seq / KVBLK;
  constexpr int SE = 0, SO = SDEPTH - 1;
  SLOAD(SE, 0); asm volatile("s_waitcnt vmcnt(0)" ::: "memory"); SWRITE(0, SE); __syncthreads();
  qkt(pA0, pA1, K_lds, qr, r32, hi); partialSM(pA0, pA1);
  SLOAD(SO, KVBLK); if constexpr (SDEPTH == 2) { if (2 < NT) SLOAD(SE, 2 * KVBLK); }
  SWAIT(); SWRITE(1, SO); __syncthreads();
  for (int j = 1; j + 1 < NT; j += 2) {
    SBAR(); qkt(pB0, pB1, (bf16*)((char*)K_lds + SHM_K), qr, r32, hi);
    finishSM(pA0, pA1, l_reg, pa0, pa1, pa2, pa3); SBAR();
    SLOAD(SO, (j + SDEPTH) * KVBLK); SBAR();
    pv_d0(o, vb0, pa0, pa1, pa2, pa3); partialSM(pB0, pB1);
    __syncthreads(); SWAIT(); SWRITE(0, SE);
    __syncthreads();
    SBAR(); qkt(pA0, pA1, K_lds, qr, r32, hi);
    finishSM(pB0, pB1, l_reg, pa0, pa1, pa2, pa3); SBAR();
    if (SDEPTH == 1 || j + 3 < NT) SLOAD(SE, (j + 1 + SDEPTH) * KVBLK); SBAR();
    pv_d0(o, vb0 + (int)SHM_V, pa0, pa1, pa2, pa3); partialSM(pA0, pA1);
    __syncthreads(); SWAIT(); SWRITE(1, SO);
    __syncthreads();
  }
  SBAR(); qkt(pB0, pB1, (bf16*)((char*)K_lds + SHM_K), qr, r32, hi);
  finishSM(pA0, pA1, l_reg, pa0, pa1, pa2, pa3); SBAR();
  pv_d0(o, vb0, pa0, pa1, pa2, pa3); partialSM(pB0, pB1);
  __syncthreads();
  finishSM(pB0, pB1, l_reg, pa0, pa1, pa2, pa3); SBAR();
  pv_d0(o, vb0 + (int)SHM_V, pa0, pa1, pa2, pa3);
  if (hi == 0) li_l[r32] = l_reg; asm volatile("s_waitcnt lgkmcnt(0)" ::: "memory");
  float rli[16];
#pragma unroll
  for (int r = 0; r < 16; ++r) rli[r] = __builtin_amdgcn_rcpf(li_l[crow(r, hi)]);
  bf16* Ow = Ob + (long)(wid * QBLK) * LDO;
#pragma unroll
  for (int r = 0; r < 16; ++r) { int orow = crow(r, hi);
    for (int d0 = 0; d0 < 4; ++d0) { const float v = o[d0][r] * rli[r]; Ow[(long)orow * LDO + d0 * 32 + r32] = (bf16)(cvtpk(v, v) & 0xffffu); } }
  __syncthreads();
#undef SLOAD
#undef SWRITE
#undef SWAIT
}
#undef KSWZ
#undef SBAR
}

constexpr int DM = 2048, SEQ = 8192, LCTX = 256, MROWS = SEQ + LCTX  , NLAYER = 4;
constexpr int INW = 6656, FF = 5632, FF2 = 2 * FF, HGW = 1024, PHW = 5120;
constexpr int NTILE = MROWS / 256;
constexpr float EPS = 1e-6f;

constexpr size_t MiB = 1u << 20;
constexpr size_t WS_CTL = 0, CTL_ZERO_BYTES = 1 * MiB;
constexpr size_t WS_MOD = 1 * MiB;
constexpr size_t WS_LB = WS_MOD + 512 * 1024;
constexpr size_t WS_AG = WS_LB + 64 * 1024;
constexpr size_t WS_WIN = 2 * MiB;
constexpr size_t WS_WOUT = WS_WIN + (size_t)NLAYER * INW * DM * 2;
constexpr size_t WS_WUP = WS_WOUT + (size_t)NLAYER * DM * DM * 2;
constexpr size_t WS_WDN = WS_WUP + (size_t)NLAYER * FF2 * DM * 2;
constexpr size_t WS_X = WS_WDN + (size_t)NLAYER * DM * FF * 2;
constexpr size_t WS_H = WS_X + (size_t)MROWS * DM * 4;
constexpr size_t WS_QA = WS_H + (size_t)MROWS * DM * 2;
constexpr size_t WS_KA = WS_QA + (size_t)MROWS * 1024 * 2;
constexpr size_t WS_VA = WS_KA + (size_t)MROWS * 256 * 2;
constexpr size_t WS_PH = WS_VA + (size_t)MROWS * 256 * 2;
constexpr size_t WS_MIX = WS_PH + (size_t)MROWS * PHW * 4;
constexpr size_t WS_OF = WS_MIX + (size_t)MROWS * DM * 2;
constexpr size_t WS_OB = WS_OF + (size_t)MROWS * HGW * 4;
constexpr size_t WS_U = WS_OB + (size_t)MROWS * HGW * 4;
constexpr size_t WS_SS = WS_U + (size_t)16 * 33 * 16384 * 4;
constexpr size_t WS_HALO = WS_SS + (size_t)16 * 33 * 16384 * 4;
constexpr size_t WS_ACT = WS_HALO + (size_t)NTILE * 6 * FF * 4;
constexpr int NSPLIT_O = 16, NSPLIT_D = 22;
constexpr size_t WS_PARTO = WS_ACT + (size_t)MROWS * FF * 2;
constexpr size_t WS_PARTD = WS_PARTO + (size_t)NSPLIT_O * 256 * DM * 4;
constexpr size_t WS_END = WS_PARTD + (size_t)NSPLIT_D * 256 * DM * 4;

constexpr int CW_BAR = 4096;

constexpr int RING_BYTES = 131072, LDSX_OFF = RING_BYTES, MISC_OFF = RING_BYTES + 12288, LDS_BYTES = 147456;

#define GAS __attribute__((address_space(1)))
#define LAS __attribute__((address_space(3)))
typedef unsigned short bf16;
typedef unsigned v4u __attribute__((ext_vector_type(4)));
typedef unsigned v2u __attribute__((ext_vector_type(2)));
typedef float f32x4 __attribute__((ext_vector_type(4)));
typedef short bf16x8 __attribute__((ext_vector_type(8)));
typedef short s16x4 __attribute__((ext_vector_type(4)));
#define LDS_WAIT() asm volatile("s_waitcnt lgkmcnt(0)" ::: "memory")
#define VM_WAIT() asm volatile("s_waitcnt vmcnt(0)" ::: "memory")
__device__ __forceinline__ unsigned f2bf(float f) { unsigned u = __builtin_bit_cast(unsigned, f); return (u + 0x7fffu + ((u >> 16) & 1u)) >> 16; }
typedef float f32x2_t __attribute__((ext_vector_type(2))); typedef __bf16 bf16x2_t __attribute__((ext_vector_type(2)));
__device__ __forceinline__ unsigned pk2(float lo, float hi) { f32x2_t v = {lo, hi}; bf16x2_t b = __builtin_convertvector(v, bf16x2_t); return __builtin_bit_cast(unsigned, b); }
__device__ __forceinline__ float silu(float x) { return x / (1.f + __expf(-x)); }

#define XB_TMO      128
#define XB_XCNT(j)  (256  + 64 * (j))
#define XB_XSUB(j)  (1280 + 64 * (j))
#define XB_XGEN(j)  (2304 + 64 * (j))
#define XB_TOP      3328
#define XB_TOPGEN   3392
#define XCD_BAR_WORDS 3456
#define XB_SPIN_CAP (1u << 18)
__device__ __forceinline__ unsigned xb_ld(unsigned* p)              { return __hip_atomic_load(p, __ATOMIC_RELAXED, __HIP_MEMORY_SCOPE_AGENT); }
__device__ __forceinline__ unsigned xb_add(unsigned* p, unsigned v) { return __hip_atomic_fetch_add(p, v, __ATOMIC_RELAXED, __HIP_MEMORY_SCOPE_AGENT); }
__device__ __forceinline__ unsigned xb_xcc_id() { return (unsigned)__builtin_amdgcn_s_getreg((3 << 11) | 20) & 0xFu; }
#define XB_SPIN(cond, bar) do { unsigned _sp = 0; while (cond) { __builtin_amdgcn_s_sleep(1); \
    if ((++_sp & 255u) == 0u) { if (xb_ld(&(bar)[XB_TMO])) break; if (_sp > XB_SPIN_CAP) { atomicAdd(&(bar)[XB_TMO], 1u); break; } } } } while (0)
struct XcdBarrier { unsigned* bar; unsigned x; volatile LAS unsigned* st; };
__device__ __forceinline__ XcdBarrier xcd_barrier_post(unsigned* bar, volatile LAS unsigned* st) {
    XcdBarrier b; b.bar = bar; b.x = xb_xcc_id(); b.st = st;
    if (threadIdx.x == 0) (void)xb_add(&bar[XB_XCNT(b.x)], 1u);
    return b;
}
__device__ __forceinline__ void xcd_barrier_complete(unsigned* bar, unsigned x, unsigned& nloc, unsigned& nx) {
    const unsigned G = gridDim.x * gridDim.y * gridDim.z;
    unsigned sum, cnt, mine, sp = 0u;
    for (;;) {
        sum = 0u; cnt = 0u; mine = 0u;
#pragma unroll
        for (unsigned j = 0; j < 16; ++j) { const unsigned c = xb_ld(&bar[XB_XCNT(j)]); sum += c; cnt += (c > 0u) ? 1u : 0u; mine = (j == x) ? c : mine; }
        if (sum == G) break;
        __builtin_amdgcn_s_sleep(1);
        if ((++sp & 255u) == 0u) { if (xb_ld(&bar[XB_TMO])) break; if (sp > XB_SPIN_CAP) { atomicAdd(&bar[XB_TMO], 1u); break; } }
    }
    nloc = mine > 0u ? mine : 1u; nx = cnt > 0u ? cnt : 1u;
}
__device__ __forceinline__ void xcd_barrier(const XcdBarrier& b) {
    asm volatile("s_waitcnt vmcnt(0)" ::: "memory");
    __syncthreads();
    if (threadIdx.x == 0) {
        unsigned* bar = b.bar;
        __builtin_amdgcn_s_waitcnt(0);
        unsigned nloc = b.st[0], nx = b.st[1];
        if (nloc == 0u) { xcd_barrier_complete(bar, b.x, nloc, nx); b.st[0] = nloc; b.st[1] = nx; }
        const unsigned old = xb_add(&bar[XB_XSUB(b.x)], 1u);
        const unsigned gen = old / nloc;
        if (old + 1u == (gen + 1u) * nloc) {
            __builtin_amdgcn_fence(__ATOMIC_RELEASE, "agent");
            asm volatile("s_waitcnt vmcnt(0)" ::: "memory");
            const unsigned og = xb_add(&bar[XB_TOP], 1u);
            const unsigned tg = og / nx;
            if (og + 1u == (tg + 1u) * nx) xb_add(&bar[XB_TOPGEN], 1u);
            else XB_SPIN(xb_ld(&bar[XB_TOPGEN]) == tg, bar);
            __builtin_amdgcn_fence(__ATOMIC_ACQUIRE, "agent");
            xb_add(&bar[XB_XGEN(b.x)], 1u);
            asm volatile("s_waitcnt vmcnt(0)" ::: "memory");
        } else {
            XB_SPIN(xb_ld(&bar[XB_XGEN(b.x)]) == gen, bar);
            __builtin_amdgcn_fence(__ATOMIC_ACQUIRE, "agent");
            asm volatile("s_waitcnt vmcnt(0)" ::: "memory");
        }
    }
    __syncthreads();
}

__device__ __attribute__((noinline)) void xcd_barrier_call(unsigned* barp, unsigned x, volatile LAS unsigned* st) { XcdBarrier b; b.bar = barp; b.x = x; b.st = st; xcd_barrier(b); }

__device__ __forceinline__ float wave_sum(float v) {
#pragma unroll
    for (int o = 1; o < 64; o <<= 1) v += __shfl_xor(v, o);
    return v;
}
__device__ __forceinline__ int rowmap(int mode, int n) {
    if (mode == 1) { if (n >= 1280) return n; const int hb = n & ~127, d = n & 127, f = d & 31;
        return hb + 64 * (d >> 6) + 32 * (f >> 4) + 8 * ((f >> 2) & 3) + 4 * ((d >> 5) & 1) + (d & 3); }
    if (mode == 2) { if (n < FF) return (n >> 7) * 256 + (n & 127); const int c = n - FF; return (c >> 7) * 256 + 128 + (c & 127); }
    return n;
}
__device__ __forceinline__ void transpose_item(const float* W, int K, int N, bf16* WT, int mode, LAS float* scr, int item, int lane) {
    const int nblk = N / 32, kb = item / nblk, nb = item % nblk, k0 = 64 * kb, n0 = 32 * nb;
    { const int kr = lane >> 3, c4 = (lane & 7) * 4; f32x4 v[8];
#pragma unroll
    for (int i = 0; i < 8; ++i) v[i] = *(const f32x4*)(W + (size_t)(k0 + kr + 8 * i) * N + n0 + c4);
#pragma unroll
    for (int i = 0; i < 8; ++i) { LAS float* d = scr + (kr + 8 * i) * 33 + c4; d[0] = v[i][0]; d[1] = v[i][1]; d[2] = v[i][2]; d[3] = v[i][3]; } }
    LDS_WAIT(); asm volatile("" ::: "memory");
    const int c = lane & 7;
#pragma unroll
    for (int j = 0; j < 4; ++j) { const int n = (lane >> 3) + 8 * j; const LAS float* s = scr + (8 * c) * 33 + n;
        v4u o; o.x = pk2(s[0 * 33], s[1 * 33]); o.y = pk2(s[2 * 33], s[3 * 33]); o.z = pk2(s[4 * 33], s[5 * 33]); o.w = pk2(s[6 * 33], s[7 * 33]);
        *(v4u*)(WT + (size_t)rowmap(mode, n0 + n) * K + k0 + 8 * c) = o; }
    LDS_WAIT(); asm volatile("" ::: "memory");
}
__device__ __forceinline__ void norm_mod_row(const float* xin, float* xrow, const float* w, const float* sh, const float* sc, bf16* orow, int lane, const float* prow, int nsplit, const float* gate) {
    const f32x4* xr = (const f32x4*)xin + lane; f32x4 v[8]; float s = 0.f;
#pragma unroll
    for (int j = 0; j < 8; ++j) v[j] = xr[64 * j];
    if (prow) {
        f32x4 a[8];
#pragma unroll
        for (int j = 0; j < 8; ++j) a[j] = (f32x4){0.f, 0.f, 0.f, 0.f};
        for (int sp = 0; sp < nsplit; ++sp) {
#pragma unroll
            for (int j = 0; j < 8; ++j) a[j] += ((const f32x4*)(prow + (size_t)sp * 256 * DM))[lane + 64 * j]; }
#pragma unroll
        for (int j = 0; j < 8; ++j) { v[j] += a[j] * ((const f32x4*)gate)[lane + 64 * j]; ((f32x4*)xrow)[lane + 64 * j] = v[j]; }
    }
#pragma unroll
    for (int j = 0; j < 8; ++j) s += (v[j][0] * v[j][0] + v[j][1] * v[j][1]) + (v[j][2] * v[j][2] + v[j][3] * v[j][3]);
    const float rstd = rsqrtf(wave_sum(s) * (1.f / DM) + EPS);
    v2u* o8 = (v2u*)orow + lane;
#pragma unroll
    for (int j = 0; j < 8; ++j) { const f32x4 wv = ((const f32x4*)w)[lane + 64 * j], shv = ((const f32x4*)sh)[lane + 64 * j], scv = ((const f32x4*)sc)[lane + 64 * j];
        const f32x4 y = v[j] * rstd * wv * (scv + 1.f) + shv; v2u o; o.x = pk2(y[0], y[1]); o.y = pk2(y[2], y[3]); o8[64 * j] = o; }
}

__device__ __forceinline__ void norm_mod_row_wg(const float* xin, float* xrow, const float* w, const float* sh, const float* sc, bf16* orow, int lane, int wave, LAS float* red, const float* prow, int nsplit, const float* gate) {
    const int i4 = lane + 64 * wave;
    f32x4 v = ((const f32x4*)xin)[i4];
    if (prow) { f32x4 a = {0.f, 0.f, 0.f, 0.f};
#pragma unroll 8
        for (int sp = 0; sp < nsplit; ++sp) a += ((const f32x4*)(prow + (size_t)sp * 256 * DM))[i4];
        v += a * ((const f32x4*)gate)[i4]; ((f32x4*)xrow)[i4] = v; }
    const float s = wave_sum((v[0] * v[0] + v[1] * v[1]) + (v[2] * v[2] + v[3] * v[3]));
    __syncthreads();
    if (lane == 0) red[wave] = s;
    __syncthreads();
    float tot = 0.f;
#pragma unroll
    for (int q = 0; q < 8; ++q) tot += red[q];
    const float rstd = rsqrtf(tot * (1.f / DM) + EPS);
    const f32x4 wv = ((const f32x4*)w)[i4], shv = ((const f32x4*)sh)[i4], scv = ((const f32x4*)sc)[i4];
    const f32x4 y = v * rstd * wv * (scv + 1.f) + shv; v2u o; o.x = pk2(y[0], y[1]); o.y = pk2(y[2], y[3]); ((v2u*)orow)[i4] = o;
}

__device__ __forceinline__ float dpp_add(float v, float src_shifted) { return v + src_shifted; }
#define ROW_SHR_ADD(v, n) ((v) + __builtin_bit_cast(float, __builtin_amdgcn_update_dpp(0, __builtin_bit_cast(int, (v)), 0x110 + (n), 0xf, 0xf, false)))

constexpr int HG_QT = 0, HG_KT = 17408, HG_KH = 34816, HG_VT = 53248, HG_ET = 71680, HG_PQ = 272, HG_PS = 144;
constexpr int HG_SSQ = 73728;
template <int MODE>
__device__ __forceinline__ void hg_unit(LAS unsigned char* lds, const float* __restrict__ PH, const float* __restrict__ LBl  ,
                                        float* __restrict__ Ubuf, float* __restrict__ AG, const float* __restrict__ SS, float* __restrict__ OX, int h, int dir, int T,
                                        const float* __restrict__ OFr = nullptr, bf16* __restrict__ MIXo = nullptr, const float* __restrict__ hgw = nullptr) {
    constexpr bool OUT = MODE != 0, SUM = (MODE == 0 || MODE == 2), FUSE = MODE == 3;
    int tid = threadIdx.x; asm volatile("" : "+v"(tid));
    const int lane = tid & 63, w = __builtin_amdgcn_readfirstlane(tid >> 6), l15 = lane & 15, g = lane >> 4;
    const int hd = dir * 8 + h, grp = (dir == 0 || T == 0) ? T : (NTILE - T), col0 = 16 * w;
    f32x4 lbv[4];
#pragma unroll
    for (int k = 0; k < 4; ++k) lbv[k] = *(const f32x4*)(LBl + h * 128 + col0 + 4 * k);
    f32x4 S[8];
    if (MODE == 1 || MODE == 3) { const float* sp = SS + (size_t)(hd * NTILE + grp) * 16384 + col0 + l15;
#pragma unroll
        for (int t8 = 0; t8 < 8; ++t8)
#pragma unroll
            for (int r = 0; r < 4; ++r) S[t8][r] = sp[(16 * t8 + 4 * g + r) * 128]; }
    else {
#pragma unroll
        for (int t8 = 0; t8 < 8; ++t8) S[t8] = (f32x4){0.f, 0.f, 0.f, 0.f}; }
    float aprod = 1.f;
    LAS unsigned char* VTw = lds + HG_VT + w * 2304;
    LAS float* ET = (LAS float*)(lds + HG_ET);
    f32x4 qv[4], xv[4], vv[4];
    const int rstep = (dir == 0) ? 64 : -64;
    const float* pr = PH + (size_t)((dir == 0) ? (T * 256 + lane) : (T * 256 + 255 - lane)) * PHW + h * 128 + col0;
#define HG_LOAD() do { _Pragma("unroll") for (int k = 0; k < 4; ++k) { if (OUT) qv[k] = *(const f32x4*)(pr + 4 * k); xv[k] = *(const f32x4*)(pr + 1024 * (1 + dir) + 4 * k); vv[k] = *(const f32x4*)(pr + 3072 + 4 * k); } } while (0)
    HG_LOAD();
    f32x4 otot[4], ofv[4], gtv[4]; float hwv = 0.f;
    if (FUSE) hwv = hgw[col0 + l15];
    LAS float* SSQ = (LAS float*)(lds + HG_SSQ);
#define HG_FINISH(cc) do { _Pragma("unroll") for (int j = 0; j < 4; ++j) { f32x4 ss4 = {0.f, 0.f, 0.f, 0.f}; \
        _Pragma("unroll") for (int w2 = 0; w2 < 8; ++w2) ss4 += *(const LAS f32x4*)(SSQ + w2 * 64 + 16 * j + 4 * g); \
        _Pragma("unroll") for (int rr = 0; rr < 4; ++rr) { const float rstd = rsqrtf(ss4[rr] * (1.f / 128.f) + EPS); const float y = otot[j][rr] * rstd * hwv * silu(gtv[j][rr]); \
            const int orow = T * 256 + 255 - ((cc) * 64 + 16 * j + 4 * g + rr); MIXo[(size_t)orow * DM + 1024 + h * 128 + col0 + l15] = (bf16)(pk2(y, y) & 0xffffu); } } } while (0)
    for (int c = 0; c < 4; ++c) {
        if (c > 0) __syncthreads();
        if (FUSE && c > 0) HG_FINISH(c - 1);
        unsigned qt[8], kt[8];
        f32x4 etv[4];
#pragma unroll
        for (int k = 0; k < 4; ++k) {
            float qe[4], ke[4];
#pragma unroll
            for (int e = 0; e < 4; ++e) {
                const float x = xv[k][e], lb = lbv[k][e];
                const float sg = __builtin_amdgcn_rcpf(1.f + __expf(-x));
                const float fg = lb + (1.f - lb) * sg;
                const float kk = 1.f - fg;
                float gl = fmaxf(__logf(fg), -80.f);
                float lc = gl; lc = ROW_SHR_ADD(lc, 1); lc = ROW_SHR_ADD(lc, 2); lc = ROW_SHR_ADD(lc, 4); lc = ROW_SHR_ADD(lc, 8);
                const float elc = __expf(lc);
                const float tot = __shfl(lc, lane | 15);
                etv[k][e] = elc;
                const float kh = kk * __expf(tot - lc);
                const unsigned kv2 = pk2(kh, vv[k][e]);
                *(LAS bf16*)(lds + HG_KH + (col0 + 4 * k + e) * HG_PS + lane * 2) = (bf16)(kv2 & 0xffffu);
                *(LAS bf16*)(VTw + (4 * k + e) * HG_PS + lane * 2) = (bf16)(kv2 >> 16);
                if (OUT) { qe[e] = qv[k][e] * elc; ke[e] = kk * __builtin_amdgcn_rcpf(fmaxf(elc, 8.7565e-27f)); }
            }
            if (OUT) { qt[2 * k] = pk2(qe[0], qe[1]); qt[2 * k + 1] = pk2(qe[2], qe[3]); kt[2 * k] = pk2(ke[0], ke[1]); kt[2 * k + 1] = pk2(ke[2], ke[3]); }
        }
        if (OUT) {
            *(LAS v4u*)(lds + HG_QT + lane * HG_PQ + col0 * 2) = (v4u){qt[0], qt[1], qt[2], qt[3]}; *(LAS v4u*)(lds + HG_QT + lane * HG_PQ + col0 * 2 + 16) = (v4u){qt[4], qt[5], qt[6], qt[7]};
            *(LAS v4u*)(lds + HG_KT + lane * HG_PQ + col0 * 2) = (v4u){kt[0], kt[1], kt[2], kt[3]}; *(LAS v4u*)(lds + HG_KT + lane * HG_PQ + col0 * 2 + 16) = (v4u){kt[4], kt[5], kt[6], kt[7]};
        }
        if (l15 == 15) {
#pragma unroll
            for (int k = 0; k < 4; ++k) *(LAS f32x4*)(ET + g * 128 + col0 + 4 * k) = etv[k]; }
        if (c < 3) { pr += (ptrdiff_t)rstep * PHW; HG_LOAD(); }
        __syncthreads();
        if (FUSE) {
#pragma unroll
            for (int j = 0; j < 4; ++j)
#pragma unroll
                for (int rr = 0; rr < 4; ++rr) { const size_t orow = (size_t)(T * 256 + 255 - (c * 64 + 16 * j + 4 * g + rr));
                    ofv[j][rr] = OFr[orow * HGW + h * 128 + col0 + l15]; gtv[j][rr] = PH[orow * PHW + 4096 + h * 128 + col0 + l15]; } }
        if (SUM && tid < 128) aprod *= (ET[tid] * ET[128 + tid]) * (ET[256 + tid] * ET[384 + tid]);
#pragma unroll
        for (int j = 0; j < 4; ++j) {
            const v2u vfr = *(const LAS v2u*)(VTw + l15 * HG_PS + (16 * j + 4 * g) * 2);
            const s16x4 vf = __builtin_bit_cast(s16x4, vfr);
            if (OUT) {
                f32x4 o = {0.f, 0.f, 0.f, 0.f}, st = {0.f, 0.f, 0.f, 0.f};
#pragma unroll
                for (int kk = 0; kk < 4; ++kk) {
                    const LAS unsigned char* qp = lds + HG_QT + (16 * j + l15) * HG_PQ + (32 * kk + 4 * g) * 2;
                    const LAS unsigned char* kp = lds + HG_KT + (16 * j + l15) * HG_PQ + (32 * kk + 4 * g) * 2;
                    const v2u q0 = *(const LAS v2u*)qp, q1 = *(const LAS v2u*)(qp + 32), k0 = *(const LAS v2u*)kp, k1 = *(const LAS v2u*)(kp + 32);
                    const bf16x8 qf = __builtin_bit_cast(bf16x8, (v4u){q0.x, q0.y, q1.x, q1.y}), kf = __builtin_bit_cast(bf16x8, (v4u){k0.x, k0.y, k1.x, k1.y});
                    const bf16x8 sf = __builtin_bit_cast(bf16x8, (v4u){pk2(S[2 * kk][0], S[2 * kk][1]), pk2(S[2 * kk][2], S[2 * kk][3]), pk2(S[2 * kk + 1][0], S[2 * kk + 1][1]), pk2(S[2 * kk + 1][2], S[2 * kk + 1][3])});
                    o = __builtin_amdgcn_mfma_f32_16x16x32_bf16(qf, sf, o, 0, 0, 0);
                    st = __builtin_amdgcn_mfma_f32_16x16x32_bf16(kf, qf, st, 0, 0, 0);
                }
#pragma unroll
                for (int rr = 0; rr < 4; ++rr) if (4 * g + rr > l15) st[rr] = 0.f;
                const s16x4 pf = __builtin_bit_cast(s16x4, (v2u){pk2(st[0], st[1]), pk2(st[2], st[3])});
                const f32x4 oi = __builtin_amdgcn_mfma_f32_16x16x16bf16_1k(pf, vf, (f32x4){0.f, 0.f, 0.f, 0.f}, 0, 0, 0);
                o += oi;
                if (FUSE) otot[j] = o + ofv[j];
                else {
#pragma unroll
                for (int rr = 0; rr < 4; ++rr) { const int tt = c * 64 + 16 * j + 4 * g + rr; const int orow = (dir == 0) ? (T * 256 + tt) : (T * 256 + 255 - tt);
                    OX[(size_t)orow * HGW + h * 128 + col0 + l15] = o[rr]; } }
            }
#pragma unroll
            for (int t8 = 0; t8 < 8; ++t8) {
                const f32x4 ev = *(const LAS f32x4*)(ET + j * 128 + 16 * t8 + 4 * g);
                const v2u kh = *(const LAS v2u*)(lds + HG_KH + (16 * t8 + l15) * HG_PS + (16 * j + 4 * g) * 2);
                S[t8] = __builtin_amdgcn_mfma_f32_16x16x16bf16_1k(__builtin_bit_cast(s16x4, kh), vf, S[t8] * ev, 0, 0, 0);
            }
        }
        if (FUSE) {
#pragma unroll
            for (int j = 0; j < 4; ++j) { f32x4 q4 = otot[j] * otot[j];
#pragma unroll
                for (int rr = 0; rr < 4; ++rr) { float v = q4[rr]; v = ROW_SHR_ADD(v, 1); v = ROW_SHR_ADD(v, 2); v = ROW_SHR_ADD(v, 4); v = ROW_SHR_ADD(v, 8); q4[rr] = v; }
                if (l15 == 15) *(LAS f32x4*)(SSQ + w * 64 + 16 * j + 4 * g) = q4; } }
    }
#undef HG_LOAD
    if (SUM) {
        float* up = Ubuf + (size_t)(hd * NTILE + grp) * 16384 + col0 + l15;
#pragma unroll
        for (int t8 = 0; t8 < 8; ++t8)
#pragma unroll
            for (int r = 0; r < 4; ++r) up[(16 * t8 + 4 * g + r) * 128] = S[t8][r];
        if (tid < 128) AG[(hd * NTILE + grp) * 128 + tid] = aprod;
    }
    VM_WAIT();
    __syncthreads();
    if (FUSE) { HG_FINISH(3); __syncthreads(); }
#undef HG_FINISH
}

constexpr int NWAVES = 8;
enum { PH_PRO = 0, PH_NORM1 = 1, PH_INPROJ = 2, PH_ATTN = 3, PH_HG1 = 4, PH_HG2 = 5, PH_HG3 = 6, PH_HGOUT = 7, PH_OUTPROJ = 8, PH_NORM2 = 9, PH_UP = 10, PH_CONV = 11, PH_DOWN = 12, PH_FINAL = 13, PH_COUNT = 14 };
struct Args { const float* in[19]; float* out; unsigned char* ws; int ph_lo, ph_hi, l_lo, l_hi, use_bar, pad; };

__global__ void __launch_bounds__(NWAVES * 64, 2) fwd_kernel(Args args) {
    extern __shared__ __attribute__((aligned(16))) unsigned char lds_raw[];
    LAS unsigned char* lds = (LAS unsigned char*)lds_raw;
    volatile LAS unsigned* MISC = (volatile LAS unsigned*)(lds + MISC_OFF);
    const int G = gridDim.x; const int bx = blockIdx.x; const int vcu = (G % 8 == 0) ? (bx % 8) * (G / 8) + bx / 8 : bx;
    if (threadIdx.x < 64) MISC[threadIdx.x] = 0u;
    __syncthreads();
    XcdBarrier bar; bar.bar = (unsigned*)(args.ws + WS_CTL) + CW_BAR; bar.x = 0; bar.st = nullptr;
#if MK_ONE_LAUNCH
    bar = xcd_barrier_post((unsigned*)(args.ws + WS_CTL) + CW_BAR, MISC + 8);
#define GRID_BAR() xcd_barrier_call(bar.bar, bar.x, bar.st)
#define IN(k) true
#else
    const bool use_bar = args.use_bar != 0;
    if (use_bar) bar = xcd_barrier_post((unsigned*)(args.ws + WS_CTL) + CW_BAR, MISC + 8);
#define GRID_BAR() do { if (use_bar) xcd_barrier(bar); } while (0)
    const int lo = args.ph_lo, hi = args.ph_hi;
#define IN(k) (lo <= (k) && (k) < hi)
#endif
#define PHASE_BEGIN() size_t wsz_ = 0; asm volatile("" : "+s"(wsz_)); unsigned char* ws = args.ws + wsz_; int tid = threadIdx.x; asm volatile("" : "+v"(tid)); \
    const int lane = tid & 63, wave = __builtin_amdgcn_readfirstlane(tid >> 6); const int gw = vcu * NWAVES + wave, NGW = G * NWAVES; const int gt = vcu * (NWAVES * 64) + tid, NGT = G * NWAVES * 64; \
    (void)lane; (void)wave; (void)gw; (void)NGW; (void)gt; (void)NGT
#define WSP(T, off) ((T*)(ws + (off)))

    if (IN(PH_PRO)) {
        PHASE_BEGIN();
        const float* w_in = args.in[8]; const float* w_out = args.in[13]; const float* w_up = args.in[14]; const float* w_down = args.in[17];
        bf16* WIN = WSP(bf16, WS_WIN); bf16* WOUT = WSP(bf16, WS_WOUT); bf16* WUP = WSP(bf16, WS_WUP); bf16* WDN = WSP(bf16, WS_WDN);
        LAS float* scr = (LAS float*)(lds + wave * 16384);
        constexpr int I_IN = (DM / 64) * (INW / 32), I_OUT = (DM / 64) * (DM / 32), I_UP = (DM / 64) * (FF2 / 32), I_DN = (FF / 64) * (DM / 32), I_L = I_IN + I_OUT + I_UP + I_DN;
        for (int it = gw; it < NLAYER * I_L; it += NGW) {
            const int l = it / I_L; int r = it % I_L;
            if (r < I_IN) { transpose_item(w_in + (size_t)l * DM * INW, DM, INW, WIN + (size_t)l * INW * DM, 1, scr, r, lane); continue; } r -= I_IN;
            if (r < I_OUT) { transpose_item(w_out + (size_t)l * DM * DM, DM, DM, WOUT + (size_t)l * DM * DM, 0, scr, r, lane); continue; } r -= I_OUT;
            if (r < I_UP) { transpose_item(w_up + (size_t)l * DM * FF2, DM, FF2, WUP + (size_t)l * FF2 * DM, 2, scr, r, lane); continue; } r -= I_UP;
            transpose_item(w_down + (size_t)l * FF * DM, FF, DM, WDN + (size_t)l * DM * FF, 0, scr, r, lane);
        }
        { const float* hg_lb_logits = args.in[11]; float* LB = WSP(float, WS_LB);
        for (int i = gt; i < 2 * 1024; i += NGT) { const int d = i / 1024, k = i % 1024; float lg[4], mx = -1e30f;
#pragma unroll
            for (int l = 0; l < 4; ++l) { lg[l] = hg_lb_logits[(d * 4 + l) * 1024 + k]; mx = fmaxf(mx, lg[l]); }
            float den = 0.f;
#pragma unroll
            for (int l = 0; l < 4; ++l) { lg[l] = __expf(lg[l] - mx); den += lg[l]; }
            float cum = 0.f;
#pragma unroll
            for (int l = 0; l < 4; ++l) { const float sm = lg[l] / den; if (l > 0) cum += sm; LB[(d * 4 + l) * 1024 + k] = cum; } } }
        __syncthreads();
        { const float* in_c = args.in[1]; const float* in_cctx = args.in[3]; const float* w_mod = args.in[4]; const float* b_mod = args.in[5]; float* MOD = WSP(float, WS_MOD);
        LAS float* sv = (LAS float*)(lds + 0);
        LAS float* red = (LAS float*)(lds + 16384);
        for (int i = tid; i < 2 * DM; i += NWAVES * 64) { const float cv = (i < DM) ? in_c[i] : in_cctx[i - DM]; sv[i] = silu(cv); }
        __syncthreads();
        for (int it = vcu; it < NLAYER * 64; it += G) {
            const int l = it >> 6, c0 = (it & 63) * 192; const int kq = tid / 48, cq = tid % 48;
            f32x4 a0 = {0.f, 0.f, 0.f, 0.f}, a1 = {0.f, 0.f, 0.f, 0.f};
            if (tid < 480) { const float* wp = w_mod + (size_t)l * DM * 12288 + c0 + 4 * cq;
#pragma unroll 8
                for (int k = kq; k < DM; k += 10) { const f32x4 wv = *(const f32x4*)(wp + (size_t)k * 12288); a0 += wv * sv[k]; a1 += wv * sv[DM + k]; }
                *(LAS f32x4*)(red + (kq * 48 + cq) * 8) = a0; *(LAS f32x4*)(red + (kq * 48 + cq) * 8 + 4) = a1; }
            __syncthreads();
            if (tid < 384) { const int cq2 = tid >> 3, j = tid & 7; float sacc = 0.f;
#pragma unroll
                for (int q = 0; q < 10; ++q) sacc += red[(q * 48 + cq2) * 8 + j];
                const int which = j >> 2, col = c0 + 4 * cq2 + (j & 3);
                MOD[(l * 2 + which) * 12288 + col] = sacc + b_mod[l * 12288 + col]; }
            __syncthreads();
        } }
        GRID_BAR();
    }

#if MK_ONE_LAUNCH
    for (int l = 0; l < NLAYER; ++l) {
#else
    for (int l = args.l_lo; l < args.l_hi; ++l) {
#endif
        if (IN(PH_NORM1)) {
            PHASE_BEGIN();
            const float* modl = WSP(float, WS_MOD) + (size_t)(l * 2 + 0) * 12288; const float* modc = modl + 12288; float* X = WSP(float, WS_X); bf16* H = WSP(bf16, WS_H); const float* nw = args.in[6] + l * DM;
            const float* partd = WSP(float, WS_PARTD);
            for (int m = vcu; m < LCTX; m += G)
                norm_mod_row_wg(l > 0 ? X + (size_t)m * DM : args.in[2] + (size_t)m * DM, X + (size_t)m * DM, nw, modc, modc + DM, H + (size_t)m * DM, lane, wave, (LAS float*)lds, l > 0 ? partd + (size_t)m * DM : nullptr, NSPLIT_D, modc - 2 * 12288 + 5 * DM);
            for (int m = LCTX + gw; m < MROWS; m += NGW)
                norm_mod_row(l > 0 ? X + (size_t)m * DM : args.in[0] + (size_t)(m - LCTX) * DM, X + (size_t)m * DM, nw, modl, modl + DM, H + (size_t)m * DM, lane, nullptr, 0, nullptr);
            GRID_BAR();
        }
        if (IN(PH_INPROJ)) {
            PHASE_BEGIN();
            pg8::Gemm g{WSP(bf16, WS_H), WSP(bf16, WS_WIN) + (size_t)l * INW * DM, MROWS, INW, DM}; pg8::StaticOrder S; S.init(MROWS, INW, DM, G, bx);
            pg8::EpiInProj E{WSP(bf16, WS_QA), WSP(bf16, WS_KA), WSP(bf16, WS_VA), WSP(float, WS_PH), args.in[9] + l * 128, args.in[10] + l * 128};
            pg8::gemm_phase<pg8::EpiInProj, pg8::StaticOrder>(lds, lds + LDSX_OFF, g, S, E);
            GRID_BAR();
        }
        if (IN(PH_ATTN)) {
            PHASE_BEGIN();
            const bf16* QA = WSP(bf16, WS_QA); const bf16* KA = WSP(bf16, WS_KA); const bf16* VA = WSP(bf16, WS_VA); bf16* MIX = WSP(bf16, WS_MIX);
            for (int u = vcu; u < 256; u += G) { const long h = u >> 5, qb = u & 31;
                att::attn_dense_body(QA + ((LCTX + qb * 256) * 1024 + h * 128), KA + (h >> 2) * 128, VA + (h >> 2) * 128, MIX + ((LCTX + qb * 256) * 2048 + h * 128), MROWS, (char*)lds_raw);
                if (qb == 0) att::attn_dense_body(QA + h * 128, KA + (h >> 2) * 128, VA + (h >> 2) * 128, MIX + h * 128, LCTX, (char*)lds_raw);
            }
        }
        if (IN(PH_HG1)) {
            PHASE_BEGIN();
            for (int u = vcu; u < 16 * 32; u += G) { const int hd = u >> 5, grp = (hd < 8) ? (u & 31) : ((u + 16) & 31);
                const int dir = hd >> 3, h = hd & 7; const int T = (dir == 0 || grp == 0) ? grp : (NTILE - grp);
                if (grp == 0) hg_unit<2>(lds, WSP(float, WS_PH), WSP(float, WS_LB) + (dir * 4 + l) * 1024, WSP(float, WS_U), WSP(float, WS_AG), nullptr, dir == 0 ? WSP(float, WS_OF) : WSP(float, WS_OB), h, dir, 0);
                else hg_unit<0>(lds, WSP(float, WS_PH), WSP(float, WS_LB) + (dir * 4 + l) * 1024, WSP(float, WS_U), WSP(float, WS_AG), nullptr, nullptr, h, dir, T); }
            GRID_BAR();
        }
        if (IN(PH_HG2)) {
            PHASE_BEGIN();
            const float* UB = WSP(float, WS_U); const float* AG = WSP(float, WS_AG); float* SS = WSP(float, WS_SS);
            for (int e = gt; e < 16 * 16384; e += NGT) { const int hd = e >> 14, idx = e & 16383, dk = idx >> 7; float sacc = 0.f;
                const float* up = UB + (size_t)hd * NTILE * 16384 + idx; const float* ap = AG + hd * NTILE * 128 + dk; float* sp = SS + (size_t)hd * NTILE * 16384 + idx;
#pragma unroll 4
                for (int gI = 0; gI < NTILE; ++gI) { sp[(size_t)gI * 16384] = sacc; if (gI < NTILE - 1) sacc = ap[gI * 128] * sacc + up[(size_t)gI * 16384]; } }
            { const float* hw = args.in[12] + l * 128; const float* OF = WSP(float, WS_OF); const float* OB = WSP(float, WS_OB); const float* PH = WSP(float, WS_PH); bf16* MIX = WSP(bf16, WS_MIX);
            for (int m = gw; m < LCTX; m += NGW) {
#pragma unroll
                for (int p = 0; p < 4; ++p) { const int col = p * 256 + lane * 4; const int dv = (lane & 31) * 4;
                    const f32x4 a = *(const f32x4*)(OF + (size_t)m * HGW + col), b = *(const f32x4*)(OB + (size_t)m * HGW + col); const f32x4 o = a + b;
                    float sq = (o[0] * o[0] + o[1] * o[1]) + (o[2] * o[2] + o[3] * o[3]);
#pragma unroll
                    for (int sh = 1; sh < 32; sh <<= 1) sq += __shfl_xor(sq, sh);
                    const float rstd = rsqrtf(sq * (1.f / 128.f) + EPS);
                    const f32x4 wv = *(const f32x4*)(hw + dv), gt4 = *(const f32x4*)(PH + (size_t)m * PHW + 4096 + col);
                    f32x4 y = o * rstd * wv; y = (f32x4){y[0] * silu(gt4[0]), y[1] * silu(gt4[1]), y[2] * silu(gt4[2]), y[3] * silu(gt4[3])};
                    v2u w2; w2.x = pk2(y[0], y[1]); w2.y = pk2(y[2], y[3]); *(v2u*)(MIX + (size_t)m * DM + 1024 + col) = w2; } } }
            GRID_BAR();
        }
        if (IN(PH_HG3)) {
            PHASE_BEGIN();
            for (int u = vcu; u < 8 * 32; u += G) { const int h = u >> 5, T = 1 + (u & 31);
                hg_unit<1>(lds, WSP(float, WS_PH), WSP(float, WS_LB) + (0 * 4 + l) * 1024, nullptr, nullptr, WSP(float, WS_SS), WSP(float, WS_OF), h, 0, T);
                hg_unit<3>(lds, WSP(float, WS_PH), WSP(float, WS_LB) + (1 * 4 + l) * 1024, nullptr, nullptr, WSP(float, WS_SS), nullptr, h, 1, T, WSP(float, WS_OF), WSP(bf16, WS_MIX), args.in[12] + l * 128); }
            GRID_BAR();
        }
        if (IN(PH_OUTPROJ)) {
            PHASE_BEGIN();
            const float* modl = WSP(float, WS_MOD) + (size_t)(l * 2 + 0) * 12288;
            pg8::Gemm g{WSP(bf16, WS_MIX), WSP(bf16, WS_WOUT) + (size_t)l * DM * DM, MROWS, DM, DM}; pg8::ResidOrder S; S.init(DM, G, bx, l < NLAYER - 1, NSPLIT_O);
            pg8::EpiResid E{WSP(float, WS_X), l == 0 ? args.in[0] - (size_t)LCTX * DM : WSP(float, WS_X), modl + 2 * DM, WSP(float, WS_PARTO)};
            pg8::gemm_phase<pg8::EpiResid, pg8::ResidOrder>(lds, lds + LDSX_OFF, g, S, E);
            GRID_BAR();
        }
        if (IN(PH_NORM2)) {
            PHASE_BEGIN();
            const float* modl = WSP(float, WS_MOD) + (size_t)(l * 2 + 0) * 12288; const float* modc = modl + 12288; float* X = WSP(float, WS_X); bf16* H = WSP(bf16, WS_H); const float* nw = args.in[7] + l * DM;
            const float* parto = WSP(float, WS_PARTO);
            if (l < NLAYER - 1) for (int m = vcu; m < LCTX; m += G)
                norm_mod_row_wg(l == 0 ? args.in[2] + (size_t)m * DM : X + (size_t)m * DM, X + (size_t)m * DM, nw, modc + 3 * DM, modc + 4 * DM, H + (size_t)m * DM, lane, wave, (LAS float*)lds, parto + (size_t)m * DM, NSPLIT_O, modc + 2 * DM);
            for (int m = LCTX + gw; m < MROWS; m += NGW)
                norm_mod_row(X + (size_t)m * DM, X + (size_t)m * DM, nw, modl + 3 * DM, modl + 4 * DM, H + (size_t)m * DM, lane, nullptr, 0, nullptr);
            GRID_BAR();
        }
        if (IN(PH_UP)) {
            PHASE_BEGIN();
            pg8::Gemm g{WSP(bf16, WS_H), WSP(bf16, WS_WUP) + (size_t)l * FF2 * DM, MROWS, FF2, DM}; pg8::StaticOrder S;
            if (l < NLAYER - 1) S.init(MROWS, FF2, DM, G, bx); else S.init(SEQ, FF2, DM, G, bx, 1);
            pg8::EpiUpConv E{WSP(bf16, WS_ACT), WSP(float, WS_HALO), args.in[15] + (size_t)l * 3 * FF, args.in[16] + (size_t)l * FF};
            pg8::gemm_phase<pg8::EpiUpConv, pg8::StaticOrder>(lds, lds + LDSX_OFF, g, S, E);
            GRID_BAR();
        }
        if (IN(PH_CONV)) {
            PHASE_BEGIN();
            const float* cw = args.in[15] + (size_t)l * 3 * FF; const float* cb = args.in[16] + (size_t)l * FF; const float* HALO = WSP(float, WS_HALO); bf16* ACT = WSP(bf16, WS_ACT);
            for (int i = gt; i < 31 * 2 * (FF / 4); i += NGT) { const int c = (i % (FF / 4)) * 4, rb = i / (FF / 4), b = 1 + (rb >> 1), second = rb & 1;
                const float* ha = HALO + (size_t)b * 6 * FF + c; const float* hn = HALO + (size_t)(b + 1) * 6 * FF + c;
                const f32x4 w0 = *(const f32x4*)(cw + c), w1 = *(const f32x4*)(cw + FF + c), w2 = *(const f32x4*)(cw + 2 * FF + c), bb = *(const f32x4*)(cb + c);
                f32x4 gp, gc, gn, up; int row;
                if (!second) { gp = *(const f32x4*)(ha + 2 * FF); gc = *(const f32x4*)(ha + 3 * FF); gn = *(const f32x4*)(hn); up = *(const f32x4*)(ha + 5 * FF); row = 256 * b + 255; }
                else         { gp = *(const f32x4*)(ha + 3 * FF); gc = *(const f32x4*)(hn); gn = *(const f32x4*)(hn + FF); up = *(const f32x4*)(hn + 4 * FF); row = 256 * (b + 1); }
                const f32x4 z = gp * w0 + gc * w1 + gn * w2 + bb;
                v2u o; o.x = pk2(silu(z[0]) * up[0], silu(z[1]) * up[1]); o.y = pk2(silu(z[2]) * up[2], silu(z[3]) * up[3]);
                *(v2u*)(ACT + (size_t)row * FF + c) = o; }
            GRID_BAR();
        }
        if (IN(PH_DOWN)) {
            PHASE_BEGIN();
            const float* modl = WSP(float, WS_MOD) + (size_t)(l * 2 + 0) * 12288;
            pg8::Gemm g{WSP(bf16, WS_ACT), WSP(bf16, WS_WDN) + (size_t)l * DM * FF, MROWS, DM, FF}; pg8::ResidOrder S; S.init(FF, G, bx, l < NLAYER - 1, NSPLIT_D);
            pg8::EpiResid E{WSP(float, WS_X), WSP(float, WS_X), modl + 5 * DM, WSP(float, WS_PARTD)};
            pg8::gemm_phase<pg8::EpiResid, pg8::ResidOrder>(lds, lds + LDSX_OFF, g, S, E);
            GRID_BAR();
        }
    }
    if (IN(PH_FINAL)) {
        PHASE_BEGIN();
        const float* X = WSP(float, WS_X); const float* fw = args.in[18];
        for (int m = gw; m < SEQ; m += NGW) { const f32x4* xr = (const f32x4*)(X + (size_t)(LCTX + m) * DM) + lane; f32x4 v[8]; float sq = 0.f;
#pragma unroll
            for (int j = 0; j < 8; ++j) { v[j] = xr[64 * j]; sq += (v[j][0] * v[j][0] + v[j][1] * v[j][1]) + (v[j][2] * v[j][2] + v[j][3] * v[j][3]); }
            const float rstd = rsqrtf(wave_sum(sq) * (1.f / DM) + EPS);
            f32x4* o = (f32x4*)(args.out + (size_t)m * DM) + lane;
#pragma unroll
            for (int j = 0; j < 8; ++j) o[64 * j] = v[j] * rstd * ((const f32x4*)fw)[lane + 64 * j]; }
    }
#undef IN
#undef GRID_BAR
#undef PHASE_BEGIN
#undef WSP
}

extern "C" void kernel_launch(void* const* d_in, const int* in_sizes, int n_in, void* d_out, int out_size, void* d_ws, size_t ws_size, hipStream_t stream) {
    static int grid = 0;
    if (grid == 0) {
        if (n_in != 19 || in_sizes[0] != SEQ * DM || out_size != SEQ * DM || ws_size < WS_END) {
            fprintf(stderr, "kernel_launch: unexpected shapes: n_in %d in0 %d out %d ws %zu (need %zu)\n", n_in, n_in > 0 ? in_sizes[0] : -1, out_size, ws_size, (size_t)WS_END); grid = -1; return; }
        int dev = 0, cus = 0;
        if (hipGetDevice(&dev) != hipSuccess || hipDeviceGetAttribute(&cus, hipDeviceAttributeMultiprocessorCount, dev) != hipSuccess) { grid = -1; return; }
        if (hipFuncSetAttribute((const void*)fwd_kernel, hipFuncAttributeMaxDynamicSharedMemorySize, LDS_BYTES) != hipSuccess) { fprintf(stderr, "kernel_launch: hipFuncSetAttribute failed\n"); grid = -1; return; }
        int per_cu = 0;
        if (hipOccupancyMaxActiveBlocksPerMultiprocessor(&per_cu, (const void*)fwd_kernel, NWAVES * 64, LDS_BYTES) != hipSuccess || per_cu < 1) fprintf(stderr, "kernel_launch: occupancy query says %d\n", per_cu);
        (void)hipGetLastError();
        grid = cus;
    }
    if (grid < 0) return;
    (void)hipMemsetAsync((char*)d_ws + WS_CTL, 0, CTL_ZERO_BYTES, stream);
    Args a{};
    for (int i = 0; i < 19; ++i) a.in[i] = (const float*)d_in[i];
    a.out = (float*)d_out; a.ws = (unsigned char*)d_ws;
#if MK_ONE_LAUNCH
    a.ph_lo = 0; a.ph_hi = PH_COUNT; a.l_lo = 0; a.l_hi = NLAYER; a.use_bar = 1;
    hipLaunchKernelGGL(fwd_kernel, dim3(grid), dim3(NWAVES * 64), LDS_BYTES, stream, a);
#else
    a.use_bar = 0;
    a.ph_lo = PH_PRO; a.ph_hi = PH_PRO + 1; a.l_lo = 0; a.l_hi = 0;
    hipLaunchKernelGGL(fwd_kernel, dim3(grid), dim3(NWAVES * 64), LDS_BYTES, stream, a);
    for (int l = 0; l < NLAYER; ++l)
        for (int p = PH_NORM1; p <= PH_DOWN; ++p) { a.ph_lo = p; a.ph_hi = p + 1; a.l_lo = l; a.l_hi = l + 1;
            hipLaunchKernelGGL(fwd_kernel, dim3(grid), dim3(NWAVES * 64), LDS_BYTES, stream, a); }
    a.ph_lo = PH_FINAL; a.ph_hi = PH_FINAL + 1; a.l_lo = 0; a.l_hi = 0;
    hipLaunchKernelGGL(fwd_kernel, dim3(grid), dim3(NWAVES * 64), LDS_BYTES, stream, a);
#endif
    const hipError_t le = hipPeekAtLastError();
    if (le != hipSuccess) fprintf(stderr, "kernel_launch: launch failed: %s\n", hipGetErrorName(le));
}
```

```cpp
#include <hip/hip_runtime.h>
#include <cstdio>
#include <cstdint>

#ifndef MK_ONE_LAUNCH
#define MK_ONE_LAUNCH 1
#endif

namespace pg8 {
#define PG8_LAS __attribute__((address_space(3)))
typedef unsigned short bf16_t;
typedef short bf16x8 __attribute__((ext_vector_type(8)));
typedef float f32x4 __attribute__((ext_vector_type(4)));
typedef unsigned u32x4 __attribute__((ext_vector_type(4)));
constexpr int BM = 256, BK = 64, HALF = 128, HTB = HALF * BK * 2, STAGE_BYTES = 8 * HTB, NXCD = 8, WGM = 8;

__host__ __device__ __forceinline__ int lds_byte(int r, int c) { const int st = (r >> 4) * 2 + (c >> 5), rr = r & 15, cc = c & 31, ob = rr * 64 + cc * 2; return st * 1024 + (ob ^ (((ob >> 9) & 1) << 5)); }
__host__ __device__ __forceinline__ void stage_rc(int b, int& R, int& C) { const int st = b / 1024, sb = b % 1024, swz = sb ^ (((sb >> 9) & 1) << 5); R = (st >> 1) * 16 + swz / 64; C = (st & 1) * 32 + (swz % 64) / 2; }
__host__ __device__ __forceinline__ int perm32(int rho) { const int n = rho >> 4, i = rho & 15; return 8 * (i >> 2) + 4 * n + (i & 3); }

struct Unit { int pm, pn, kt0, nkt, part; };
struct Gemm { const bf16_t* A; const bf16_t* Bt; int M, N, K; };

struct StaticOrder {
    int nM, nN, nwg, G, c, nkt, pm0;
    __host__ __device__ void init(int M, int N, int K, int G_, int c_, int pm0_ = 0) { nM = M / BM; nN = N / BM; nwg = nM * nN; G = G_; c = c_; nkt = K / BK; pm0 = pm0_; }
    __host__ __device__ bool next(int i, Unit& u) const { return by_index((long)i * G + c, u); }
    __host__ __device__ bool by_index(long L, Unit& u) const {
        if (L >= nwg) return false;
        int wgid = (int)L; { const int q = nwg / NXCD, r = nwg % NXCD, xcd = wgid % NXCD, off = wgid / NXCD; wgid = (xcd < r ? xcd * (q + 1) : r * (q + 1) + (xcd - r) * q) + off; }
        const int nig = WGM * nN, gid = wgid / nig, fm = gid * WGM, gsz = (nM - fm) < WGM ? (nM - fm) : WGM;
        u.pm = pm0 + fm + ((wgid % nig) % gsz); u.pn = (wgid % nig) / gsz; u.kt0 = 0; u.nkt = nkt; u.part = -1; return true;
    }
    __device__ __forceinline__ void a_ready(const Unit&) const {}
    __device__ __forceinline__ void done(const Unit&) const {}
};

struct ResidOrder {
    int G, c, nkt, nsplit, skt, with_ctx;
    __host__ __device__ void init(int K, int G_, int c_, bool with_ctx_, int nsplit_) { G = G_; c = c_; nkt = K / BK; with_ctx = with_ctx_ ? 1 : 0; nsplit = nsplit_; skt = (K / BK) / nsplit_; }
    __host__ __device__ bool next(int i, Unit& u) const {
        const int L = i * G + c; const bool lat = L < 256; const int j = L - 256;
        if (!lat && (!with_ctx || j >= 8 * nsplit)) return false;
        const int wgid = (L & 7) * 32 + (L >> 3), r64 = wgid & 63;
        u.pm = lat ? 1 + (wgid >> 6) * 8 + (r64 & 7) : 0; u.pn = lat ? (r64 >> 3) : (j & 7); u.part = lat ? -1 : (j >> 3); u.kt0 = lat ? 0 : (j >> 3) * skt; u.nkt = lat ? nkt : skt; return true;
    }
    __device__ __forceinline__ void a_ready(const Unit&) const {}
    __device__ __forceinline__ void done(const Unit&) const {}
};

__device__ __forceinline__ unsigned cvt_pk_bf16(float lo, float hi) { unsigned r; asm volatile("v_cvt_pk_bf16_f32 %0, %1, %2" : "=v"(r) : "v"(lo), "v"(hi)); return r; }
__device__ __forceinline__ float silu_f(float x) { return x * __builtin_amdgcn_rcpf(1.f + __expf(-x)); }


struct EpiInProj {
    static constexpr bool PERM = true;
    bf16_t* QA; bf16_t* KA; bf16_t* VA; float* PH; const float* qw; const float* kw;
    __device__ __forceinline__ void operator()(const f32x4 (&acc)[2][2][4][2], const Unit& u, int wr, int wc, int fr, int fq, PG8_LAS unsigned char* ldsx) const {
        const int row0 = u.pm * BM + wr * 64 + fr; const int pn = u.pn;
        if (pn >= 6) {
            const int colb = (pn - 6) * 256 + wc * 32 + 8 * fq; const bool act = pn < 10;
#pragma unroll
            for (int ai = 0; ai < 2; ++ai)
#pragma unroll
                for (int m = 0; m < 4; ++m) { float* rowp = PH + (size_t)(row0 + ai * HALF + m * 16) * 5120 + colb;
#pragma unroll
                    for (int bj = 0; bj < 2; ++bj) { f32x4 v0 = acc[ai][bj][m][0], v1 = acc[ai][bj][m][1];
                        if (act) { v0 = (f32x4){silu_f(v0[0]), silu_f(v0[1]), silu_f(v0[2]), silu_f(v0[3])}; v1 = (f32x4){silu_f(v1[0]), silu_f(v1[1]), silu_f(v1[2]), silu_f(v1[3])}; }
                        *(f32x4*)(rowp + bj * HALF) = v0; *(f32x4*)(rowp + bj * HALF + 4) = v1; } }
        } else if (pn == 5) {
            const int colb = wc * 32 + 8 * fq;
#pragma unroll
            for (int ai = 0; ai < 2; ++ai)
#pragma unroll
                for (int m = 0; m < 4; ++m) { bf16_t* rowp = VA + (size_t)(row0 + ai * HALF + m * 16) * 256 + colb;
#pragma unroll
                    for (int bj = 0; bj < 2; ++bj) { const f32x4 v0 = acc[ai][bj][m][0], v1 = acc[ai][bj][m][1]; u32x4 w;
                        w.x = cvt_pk_bf16(v0[0], v0[1]); w.y = cvt_pk_bf16(v0[2], v0[3]); w.z = cvt_pk_bf16(v1[0], v1[1]); w.w = cvt_pk_bf16(v1[2], v1[3]);
                        *(u32x4*)(rowp + bj * HALF) = w; } }
        } else {
            PG8_LAS float* P = (PG8_LAS float*)ldsx;
#pragma unroll
            for (int ai = 0; ai < 2; ++ai)
#pragma unroll
                for (int m = 0; m < 4; ++m)
#pragma unroll
                    for (int bj = 0; bj < 2; ++bj) { const f32x4 a = acc[ai][bj][m][0], b = acc[ai][bj][m][1];
                        float s = (a[0] * a[0] + a[1] * a[1]) + (a[2] * a[2] + a[3] * a[3]) + (b[0] * b[0] + b[1] * b[1]) + (b[2] * b[2] + b[3] * b[3]);
                        s += __shfl_xor(s, 16); s += __shfl_xor(s, 32);
                        if (fq == 0) P[((ai * HALF + wr * 64 + m * 16 + fr) * 2 + bj) * 4 + wc] = s; }
            asm volatile("s_waitcnt lgkmcnt(0)" ::: "memory"); __builtin_amdgcn_s_barrier(); asm volatile("" ::: "memory");
            const bool isq = pn < 4; const float* nw = isq ? qw : kw;
            const int dbase = (wc >> 1) * 64 + (wc & 1) * 16 + fq * 4;
            const f32x4 w0 = *(const f32x4*)(nw + dbase), w1 = *(const f32x4*)(nw + dbase + 32);
            float fr4[4];
#pragma unroll
            for (int e = 0; e < 4; ++e) fr4[e] = exp2f(-(float)((wc & 1) * 16 + fq * 4 + e) * (13.287712379549449f / 32.f));
            const bool rope = u.pm > 0;
#pragma unroll
            for (int ai = 0; ai < 2; ++ai)
#pragma unroll
                for (int m = 0; m < 4; ++m) { const int grow = row0 + ai * HALF + m * 16; const int t = grow - 256; const float pos = (float)((wc >> 1) ? (t & 63) : (t >> 6));
                    f32x4 cs, sn;
#pragma unroll
                    for (int e = 0; e < 4; ++e) { const float ang = pos * fr4[e]; cs[e] = rope ? __cosf(ang) : 1.f; sn[e] = rope ? __sinf(ang) : 0.f; }
#pragma unroll
                    for (int bj = 0; bj < 2; ++bj) { const f32x4 p = *(const PG8_LAS f32x4*)(P + ((ai * HALF + wr * 64 + m * 16 + fr) * 2 + bj) * 4);
                        const float rstd = rsqrtf(((p[0] + p[1]) + (p[2] + p[3])) * (1.f / 128.f) + 1e-6f) * (isq ? 0.12751743074602468f : 1.f);
                        const f32x4 x1 = acc[ai][bj][m][0] * rstd * w0, x2 = acc[ai][bj][m][1] * rstd * w1;
                        const f32x4 o1 = x1 * cs - x2 * sn, o2 = x2 * cs + x1 * sn; u32x4 w;
                        w.x = cvt_pk_bf16(o1[0], o1[1]); w.y = cvt_pk_bf16(o1[2], o1[3]); w.z = cvt_pk_bf16(o2[0], o2[1]); w.w = cvt_pk_bf16(o2[2], o2[3]);
                        bf16_t* dst = isq ? QA + (size_t)grow * 1024 + (2 * pn + bj) * 128 + wc * 32 + 8 * fq : KA + (size_t)grow * 256 + bj * 128 + wc * 32 + 8 * fq;
                        *(u32x4*)dst = w; } }
        }
    }
};
struct EpiResid {
    static constexpr bool PERM = false;
    float* X; const float* Xin; const float* gl; float* PART;
    __device__ __forceinline__ void operator()(const f32x4 (&acc)[2][2][4][2], const Unit& u, int wr, int wc, int fr, int fq, PG8_LAS unsigned char*) const {
        const int row0 = u.pm * BM + wr * 64 + fr, col0 = u.pn * BM + wc * 32 + 4 * fq; const float* g = gl;
        if (u.part >= 0) {
#pragma unroll
            for (int ai = 0; ai < 2; ++ai)
#pragma unroll
                for (int m = 0; m < 4; ++m) { float* rowp = PART + ((size_t)u.part * 256 + (wr * 64 + fr + ai * HALF + m * 16)) * 2048 + col0;
#pragma unroll
                    for (int bj = 0; bj < 2; ++bj)
#pragma unroll
                        for (int n = 0; n < 2; ++n) *(f32x4*)(rowp + bj * HALF + n * 16) = acc[ai][bj][m][n]; }
            return;
        }
        f32x4 gv[2][2];
#pragma unroll
        for (int bj = 0; bj < 2; ++bj)
#pragma unroll
            for (int n = 0; n < 2; ++n) gv[bj][n] = *(const f32x4*)(g + col0 + bj * HALF + n * 16);
#pragma unroll
        for (int ai = 0; ai < 2; ++ai)
#pragma unroll
            for (int m = 0; m < 4; ++m) { float* rowp = X + (size_t)(row0 + ai * HALF + m * 16) * 2048 + col0; const float* rinp = Xin + (size_t)(row0 + ai * HALF + m * 16) * 2048 + col0;
#pragma unroll
                for (int bj = 0; bj < 2; ++bj)
#pragma unroll
                    for (int n = 0; n < 2; ++n) { f32x4* p = (f32x4*)(rowp + bj * HALF + n * 16); *p = *(const f32x4*)(rinp + bj * HALF + n * 16) + gv[bj][n] * acc[ai][bj][m][n]; } }
    }
};
template <int CTRL> __device__ __forceinline__ float dppf(float v) { return __int_as_float(__builtin_amdgcn_update_dpp(0, __float_as_int(v), CTRL, 0xf, 0xf, false)); }
struct EpiUpConv {
    static constexpr bool PERM = true;
    bf16_t* ACT; float* HALO; const float* cw; const float* cb;
    __device__ __forceinline__ void operator()(const f32x4 (&acc)[2][2][4][2], const Unit& u, int wr, int wc, int fr, int fq, PG8_LAS unsigned char* ldsx) const {
        PG8_LAS float* EDGE = (PG8_LAS float*)ldsx;
        const int cg = wc * 32 + 8 * fq, ff = u.pn * 128 + cg;
        if (fr == 0) {
#pragma unroll
            for (int ai = 0; ai < 2; ++ai)
#pragma unroll
                for (int n = 0; n < 2; ++n) *(PG8_LAS f32x4*)(EDGE + ((2 * ai + wr) * 2 + 0) * 128 + cg + 4 * n) = acc[ai][0][0][n]; }
        if (fr == 15) {
#pragma unroll
            for (int ai = 0; ai < 2; ++ai)
#pragma unroll
                for (int n = 0; n < 2; ++n) *(PG8_LAS f32x4*)(EDGE + ((2 * ai + wr) * 2 + 1) * 128 + cg + 4 * n) = acc[ai][0][3][n]; }
        f32x4 w0[2], w1[2], w2[2], bb[2];
#pragma unroll
        for (int n = 0; n < 2; ++n) { w0[n] = *(const f32x4*)(cw + ff + 4 * n); w1[n] = *(const f32x4*)(cw + 5632 + ff + 4 * n); w2[n] = *(const f32x4*)(cw + 2 * 5632 + ff + 4 * n); bb[n] = *(const f32x4*)(cb + ff + 4 * n); }
        asm volatile("s_waitcnt lgkmcnt(0)" ::: "memory"); __builtin_amdgcn_s_barrier(); asm volatile("" ::: "memory");
        float* hb = HALO + (size_t)u.pm * 6 * 5632 + ff;
#pragma unroll
        for (int ai = 0; ai < 2; ++ai) {
            const int chunk = 2 * ai + wr;
            f32x4 ep[2], en[2];
#pragma unroll
            for (int n = 0; n < 2; ++n) {
                ep[n] = (chunk > 0) ? *(const PG8_LAS f32x4*)(EDGE + ((chunk - 1) * 2 + 1) * 128 + cg + 4 * n) : (f32x4){0.f, 0.f, 0.f, 0.f};
                en[n] = (chunk < 3) ? *(const PG8_LAS f32x4*)(EDGE + ((chunk + 1) * 2 + 0) * 128 + cg + 4 * n) : (f32x4){0.f, 0.f, 0.f, 0.f}; }
#pragma unroll
            for (int m = 0; m < 4; ++m) {
                const int row = u.pm * BM + ai * HALF + wr * 64 + m * 16 + fr;
                u32x4 w;
#pragma unroll
                for (int n = 0; n < 2; ++n) {
                    const f32x4 g = acc[ai][0][m][n], up = acc[ai][1][m][n]; f32x4 a;
#pragma unroll
                    for (int e = 0; e < 4; ++e) {
                        float gp = dppf<0x111>(g[e]);
                        if (m > 0) gp += dppf<0x10F>(acc[ai][0][m > 0 ? m - 1 : 0][n][e]);
                        else gp += (fr == 0) ? ep[n][e] : 0.f;
                        float gn = dppf<0x101>(g[e]);
                        if (m < 3) gn += dppf<0x11F>(acc[ai][0][m < 3 ? m + 1 : 3][n][e]);
                        else gn += (fr == 15) ? en[n][e] : 0.f;
                        const float z = w0[n][e] * gp + w1[n][e] * g[e] + w2[n][e] * gn + bb[n][e];
                        a[e] = silu_f(z) * up[e];
                    }
                    if (n == 0) { w.x = cvt_pk_bf16(a[0], a[1]); w.y = cvt_pk_bf16(a[2], a[3]); } else { w.z = cvt_pk_bf16(a[0], a[1]); w.w = cvt_pk_bf16(a[2], a[3]); }
                    if (chunk == 0 && m == 0 && fr < 2) { *(f32x4*)(hb + (size_t)fr * 5632 + 4 * n) = g; if (fr == 0) *(f32x4*)(hb + (size_t)4 * 5632 + 4 * n) = up; }
                    if (chunk == 3 && m == 3 && fr >= 14) { *(f32x4*)(hb + (size_t)(fr - 12) * 5632 + 4 * n) = g; if (fr == 15) *(f32x4*)(hb + (size_t)5 * 5632 + 4 * n) = up; }
                }
                *(u32x4*)(ACT + (size_t)row * 5632 + ff) = w;
            }
        }
    }
};
struct EpiF32 {
    static constexpr bool PERM = false;
    float* O; int ldc;
    __device__ __forceinline__ void operator()(const f32x4 (&acc)[2][2][4][2], const Unit& u, int wr, int wc, int fr, int fq, PG8_LAS unsigned char*) const {
        const int row0 = u.pm * BM + wr * 64 + fr, col0 = u.pn * BM + wc * 32 + 4 * fq;
#pragma unroll
        for (int ai = 0; ai < 2; ++ai)
#pragma unroll
            for (int m = 0; m < 4; ++m) { float* rowp = O + (size_t)(row0 + ai * HALF + m * 16) * ldc + col0;
#pragma unroll
                for (int bj = 0; bj < 2; ++bj)
#pragma unroll
                    for (int n = 0; n < 2; ++n) *(f32x4*)(rowp + bj * HALF + n * 16) = acc[ai][bj][m][n]; }
    }
};

template <class Epi, class Sched>
__device__ __forceinline__ void gemm_phase(PG8_LAS unsigned char* lds, PG8_LAS unsigned char* ldsx, const Gemm g, const Sched& S, const Epi& E) {
    int tid = threadIdx.x; asm volatile("" : "+v"(tid));
    const int wid = __builtin_amdgcn_readfirstlane(tid >> 6), lane = tid & 63, wr = wid >> 2, wc = wid & 3, fr = lane & 15, fq = lane >> 4;
    const int K = g.K;
    unsigned voffA[2], voffB[2];
#pragma unroll
    for (int i = 0; i < 2; ++i) { int R, C; stage_rc(tid * 16 + i * 8192, R, C); const int Rb = Epi::PERM ? ((R & ~31) + perm32(R & 31)) : R;
        voffA[i] = (unsigned)(R * K + C) * 2u; voffB[i] = (unsigned)(Rb * K + C) * 2u; }
    const size_t kstep = (size_t)(BK * 2);
    const size_t hstep = (size_t)HALF * K * 2;
    const size_t tstep = 2 * hstep;
    const unsigned ldsw = (unsigned)wid * 1024u;
    const int aoff = lds_byte(wr * 64 + fr, fq * 8), boff = lds_byte(wc * 32 + fr, fq * 8);
#define PG8_SA(b, h) (((b) * 2 + (h)) * HTB)
#define PG8_SB(b, h) ((4 + (b) * 2 + (h)) * HTB)
#define PG8_STAGE(bufoff, gbase, voff) do { _Pragma("unroll") for (int _i = 0; _i < 2; ++_i) \
        __builtin_amdgcn_global_load_lds((const unsigned*)((const char*)(gbase) + (voff)[_i]), (PG8_LAS unsigned*)(lds + (bufoff) + ldsw + _i * 8192), 16, 0, 0); } while (0)
#define PG8_LDA(dst, b, h) do { _Pragma("unroll") for (int m = 0; m < 4; ++m) _Pragma("unroll") for (int k = 0; k < 2; ++k) dst[m][k] = *(const PG8_LAS bf16x8*)(lds + PG8_SA(b, h) + aoff + m * 2048 + k * 1024); } while (0)
#define PG8_LDB(dst, b, h) do { _Pragma("unroll") for (int n = 0; n < 2; ++n) _Pragma("unroll") for (int k = 0; k < 2; ++k) dst[n][k] = *(const PG8_LAS bf16x8*)(lds + PG8_SB(b, h) + boff + n * 2048 + k * 1024); } while (0)
#define PG8_MMA(ai, bj, At, Bt) do { __builtin_amdgcn_s_setprio(1); _Pragma("unroll") for (int m = 0; m < 4; ++m) _Pragma("unroll") for (int n = 0; n < 2; ++n) _Pragma("unroll") for (int k = 0; k < 2; ++k) \
        acc[ai][bj][m][n] = __builtin_amdgcn_mfma_f32_16x16x32_bf16(Bt[n][k], At[m][k], acc[ai][bj][m][n], 0, 0, 0); __builtin_amdgcn_s_setprio(0); } while (0)
#define PG8_WAIT_V(n) asm volatile("s_waitcnt vmcnt(" #n ")" ::: "memory")
#define PG8_WAIT_L(n) asm volatile("s_waitcnt lgkmcnt(" #n ")" ::: "memory")
#define PG8_BAR __builtin_amdgcn_s_barrier()
#define PG8_SCHED __builtin_amdgcn_sched_barrier(0)
    Unit cur, nxt; int ui = 0;
    if (!S.next(0, cur)) return;
    f32x4 acc[2][2][4][2];
#pragma unroll
    for (int a = 0; a < 2; ++a)
#pragma unroll
        for (int b = 0; b < 2; ++b)
#pragma unroll
            for (int m = 0; m < 4; ++m)
#pragma unroll
                for (int n = 0; n < 2; ++n) acc[a][b][m][n] = (f32x4){0.f, 0.f, 0.f, 0.f};
    bf16x8 At[4][2], B0[2][2], B1[2][2];
    const char* cA = (const char*)g.A + (size_t)cur.pm * tstep + (size_t)cur.kt0 * kstep; const char* cB = (const char*)g.Bt + (size_t)cur.pn * tstep + (size_t)cur.kt0 * kstep;
    S.a_ready(cur);
    PG8_STAGE(PG8_SB(0, 0), cB, voffB); PG8_STAGE(PG8_SB(0, 1), cB + hstep, voffB); PG8_STAGE(PG8_SA(0, 0), cA, voffA); PG8_STAGE(PG8_SA(0, 1), cA + hstep, voffA);
    if (wr == 1) PG8_BAR;
    PG8_WAIT_V(2); PG8_BAR;
    PG8_STAGE(PG8_SB(1, 0), cB + kstep, voffB); PG8_STAGE(PG8_SA(1, 0), cA + kstep, voffA); PG8_STAGE(PG8_SB(1, 1), cB + hstep + kstep, voffB);
    PG8_WAIT_V(6); PG8_BAR;
    for (;;) {
        const bool has_next = S.next(ui + 1, nxt);
        const char* nA = has_next ? (const char*)g.A + (size_t)nxt.pm * tstep + (size_t)nxt.kt0 * kstep : cA; const char* nB = has_next ? (const char*)g.Bt + (size_t)nxt.pn * tstep + (size_t)nxt.kt0 * kstep : cB;
        const int nt = cur.nkt;
        for (int t = 0; t < nt; t += 2) {
            const bool last = (t == nt - 2);
            const char* a1 = cA + (size_t)(t + 1) * kstep;
            const char* a2 = last ? nA : cA + (size_t)(t + 2) * kstep; const char* b2 = last ? nB : cB + (size_t)(t + 2) * kstep;
            const char* a3 = a2 + kstep; const char* b3 = b2 + kstep;
            if (last && has_next) S.a_ready(nxt);
            PG8_LDB(B0, 0, 0); PG8_LDB(B1, 0, 1); PG8_SCHED; PG8_LDA(At, 0, 0); PG8_STAGE(PG8_SA(1, 1), a1 + hstep, voffA);
            PG8_WAIT_V(8); PG8_WAIT_L(0); PG8_BAR; PG8_MMA(0, 0, At, B0); PG8_MMA(0, 1, At, B1); PG8_BAR; PG8_SCHED;
            PG8_LDA(At, 0, 1); PG8_STAGE(PG8_SB(0, 0), b2, voffB); PG8_STAGE(PG8_SB(0, 1), b2 + hstep, voffB); PG8_STAGE(PG8_SA(0, 0), a2, voffA);
            PG8_WAIT_V(8); PG8_WAIT_L(0); PG8_BAR; PG8_MMA(1, 0, At, B0); PG8_MMA(1, 1, At, B1); PG8_BAR; PG8_SCHED;
            PG8_LDB(B0, 1, 0); PG8_LDB(B1, 1, 1); PG8_SCHED; PG8_LDA(At, 1, 0); PG8_STAGE(PG8_SA(0, 1), a2 + hstep, voffA);
            PG8_WAIT_V(8); PG8_WAIT_L(0); PG8_BAR; PG8_MMA(0, 0, At, B0); PG8_MMA(0, 1, At, B1); PG8_BAR; PG8_SCHED;
            PG8_LDA(At, 1, 1); PG8_STAGE(PG8_SB(1, 0), b3, voffB); PG8_STAGE(PG8_SB(1, 1), b3 + hstep, voffB); PG8_STAGE(PG8_SA(1, 0), a3, voffA);
            PG8_WAIT_V(8); PG8_WAIT_L(0); PG8_BAR; PG8_MMA(1, 0, At, B0); PG8_MMA(1, 1, At, B1); PG8_BAR; PG8_SCHED;
        }
        if (wr == 0) PG8_BAR;
        E(acc, cur, wr, wc, fr, fq, ldsx); S.done(cur);
        if (!has_next) break;
#pragma unroll
        for (int a = 0; a < 2; ++a)
#pragma unroll
            for (int b = 0; b < 2; ++b)
#pragma unroll
                for (int m = 0; m < 4; ++m)
#pragma unroll
                    for (int n = 0; n < 2; ++n) acc[a][b][m][n] = (f32x4){0.f, 0.f, 0.f, 0.f};
        cur = nxt; cA = nA; cB = nB; ++ui;
        if (wr == 1) PG8_BAR;
    }
    PG8_WAIT_V(0);
    PG8_BAR;
#undef PG8_SA
#undef PG8_SB
#undef PG8_STAGE
#undef PG8_LDA
#undef PG8_LDB
#undef PG8_MMA
#undef PG8_WAIT_V
#undef PG8_WAIT_L
#undef PG8_BAR
#undef PG8_SCHED
}
}

namespace att {
typedef unsigned short bf16;
using bf16x8 = __attribute__((ext_vector_type(8))) short;
using s16x4  = __attribute__((ext_vector_type(4))) short;
using f32x16 = __attribute__((ext_vector_type(16))) float;
using u32x4  = __attribute__((ext_vector_type(4))) unsigned;
constexpr int   D = 128, NW = 8, QBLK = 32, KVBLK = 64;
constexpr float SCALE = 0.088388347648318440f;
constexpr float THR = 8.f;
constexpr int SDEPTH = 1;
constexpr int LDQ = 1024, LDK = 256, LDO = 2048;
constexpr size_t SHM_V = KVBLK * D * 2, SHM_K = KVBLK * D * 2, SHM_ATTN = 3 * SHM_V + 3 * SHM_K + NW * 64 * 4;
#define KSWZ(row, colB) ((row) * 256 + ((colB) ^ (((row) & 7) << 4)))
#define SBAR() __builtin_amdgcn_sched_barrier(0)
__device__ __forceinline__ int crow(int r, int hi) { return (r & 3) + 8 * (r >> 2) + 4 * hi; }
typedef float f32x2a __attribute__((ext_vector_type(2))); typedef __bf16 bf16x2a __attribute__((ext_vector_type(2)));
__device__ __forceinline__ unsigned cvtpk(float lo, float hi) { f32x2a v = {lo, hi}; bf16x2a b = __builtin_convertvector(v, bf16x2a); return __builtin_bit_cast(unsigned, b); }
__device__ __forceinline__ void partialSM(f32x16& p0, f32x16& p1) {
  for (int r = 0; r < 16; ++r) p0[r] = __builtin_amdgcn_exp2f(p0[r]);
}
__device__ __forceinline__ void finishSM(f32x16& p0, f32x16& p1, float& l_reg, bf16x8& pa0, bf16x8& pa1, bf16x8& pa2, bf16x8& pa3) {
  for (int r = 0; r < 16; ++r) p1[r] = __builtin_amdgcn_exp2f(p1[r]);
  float ps = 0; for (int r = 0; r < 16; ++r) ps += p0[r]; for (int r = 0; r < 16; ++r) ps += p1[r];
  { auto rr = __builtin_amdgcn_permlane32_swap(__float_as_uint(ps), __float_as_uint(ps), false, false);
    ps = __uint_as_float(rr[0]) + __uint_as_float(rr[1]); }
  l_reg += ps;
#define PK4(P, BASE, OUT) do { unsigned a0 = cvtpk(P[BASE + 0], P[BASE + 1]), a1 = cvtpk(P[BASE + 2], P[BASE + 3]);   \
    unsigned b0 = cvtpk(P[BASE + 4], P[BASE + 5]), b1 = cvtpk(P[BASE + 6], P[BASE + 7]);                              \
    auto r0 = __builtin_amdgcn_permlane32_swap(a0, b0, false, false); auto r1 = __builtin_amdgcn_permlane32_swap(a1, b1, false, false); \
    u32x4 w = {r0[0], r1[0], r0[1], r1[1]}; OUT = *reinterpret_cast<bf16x8*>(&w); } while (0)
  PK4(p0, 0, pa0); PK4(p0, 8, pa1); PK4(p1, 0, pa2); PK4(p1, 8, pa3);
#undef PK4
}
__device__ __forceinline__ void qkt(f32x16& p0, f32x16& p1, const bf16* Ks, const bf16x8* qr, int r32, int hi) {
  p0 = f32x16{}; p1 = f32x16{};
  for (int d0 = 0; d0 < 8; ++d0) { int cb = (d0 * 16 + hi * 8) * 2;
    bf16x8 b0 = *reinterpret_cast<const bf16x8*>((const char*)Ks + KSWZ(r32, cb));
    bf16x8 b1 = *reinterpret_cast<const bf16x8*>((const char*)Ks + KSWZ(32 + r32, cb));
    p0 = __builtin_amdgcn_mfma_f32_32x32x16_bf16(b0, qr[d0], p0, 0, 0, 0);
    p1 = __builtin_amdgcn_mfma_f32_32x32x16_bf16(b1, qr[d0], p1, 0, 0, 0); }
}
__device__ __forceinline__ int v_st(int k, int c) { const int kk = (k & ~0xC) | ((k & 4) << 1) | ((k & 8) >> 1); return ((kk >> 3) * 4 + (c >> 5)) * 512 + ((kk & 7) * 32 + (c & 31)) * 2; }
__device__ __forceinline__ int v_rd_base(int lane) { return ((lane & 3) << 3) | (((lane >> 2) & 3) << 6) | (((lane >> 4) & 1) << 5) | (((lane >> 5) & 1) << 8); }
constexpr int v_rd_off(int d0, int ks, int half) { return d0 * 512 + ks * 4096 + half * 2048; }
typedef short v4i16_t __attribute__((ext_vector_type(4)));
template <int OFF> __device__ __forceinline__ s16x4 tr_read(int vb) {
  return __builtin_bit_cast(s16x4, __builtin_amdgcn_ds_read_tr16_b64_v4i16((__attribute__((address_space(3))) v4i16_t*)(unsigned long)(unsigned)(vb + OFF)));
}
template <int D0> __device__ __forceinline__ void pv_one(f32x16& od, int vb, bf16x8 pa0, bf16x8 pa1, bf16x8 pa2, bf16x8 pa3) {
  const s16x4 l0 = tr_read<v_rd_off(D0, 0, 0)>(vb), h0 = tr_read<v_rd_off(D0, 0, 1)>(vb), l1 = tr_read<v_rd_off(D0, 1, 0)>(vb), h1 = tr_read<v_rd_off(D0, 1, 1)>(vb);
  const s16x4 l2 = tr_read<v_rd_off(D0, 2, 0)>(vb), h2 = tr_read<v_rd_off(D0, 2, 1)>(vb), l3 = tr_read<v_rd_off(D0, 3, 0)>(vb), h3 = tr_read<v_rd_off(D0, 3, 1)>(vb);
#define PK(L, H) (bf16x8){L[0], L[1], L[2], L[3], H[0], H[1], H[2], H[3]}
  od = __builtin_amdgcn_mfma_f32_32x32x16_bf16(pa0, PK(l0, h0), od, 0, 0, 0);
  od = __builtin_amdgcn_mfma_f32_32x32x16_bf16(pa1, PK(l1, h1), od, 0, 0, 0);
  od = __builtin_amdgcn_mfma_f32_32x32x16_bf16(pa2, PK(l2, h2), od, 0, 0, 0);
  od = __builtin_amdgcn_mfma_f32_32x32x16_bf16(pa3, PK(l3, h3), od, 0, 0, 0);
#undef PK
}
__device__ __forceinline__ void pv_d0(f32x16* o, int vb, bf16x8 pa0, bf16x8 pa1, bf16x8 pa2, bf16x8 pa3) {
  pv_one<0>(o[0], vb, pa0, pa1, pa2, pa3); pv_one<1>(o[1], vb, pa0, pa1, pa2, pa3); pv_one<2>(o[2], vb, pa0, pa1, pa2, pa3); pv_one<3>(o[3], vb, pa0, pa1, pa2, pa3);
}
__device__ __forceinline__ void attn_dense_body(const bf16* __restrict__ Qb, const bf16* __restrict__ Kh, const bf16* __restrict__ Vh, bf16* __restrict__ Ob, int seq, char* lds) {
  int tid = threadIdx.x; asm volatile("" : "+v"(tid));
  const int wid = tid >> 6, lane = tid & 63, r32 = lane & 31, hi = lane >> 5;
  bf16* V_lds = (bf16*)lds; bf16* K_lds = (bf16*)(lds + 3 * SHM_V);
  float* ws = (float*)(lds + 3 * SHM_V + 3 * SHM_K) + wid * 64; float* li_l = ws;
  float l_reg = 0; f32x16 o[4] = {}; bf16x8 qr[8];
  const bf16* Qw = Qb + (long)(wid * QBLK + r32) * LDQ + hi * 8;
#pragma unroll
  for (int d0 = 0; d0 < 8; ++d0) qr[d0] = *reinterpret_cast<const bf16x8*>(Qw + d0 * 16);
  const int sr = tid >> 4, sc = (tid & 15) * 8, vst0 = v_st(sr, sc), vst1 = v_st(32 + sr, sc);
  const int vb0 = (int)(uintptr_t)V_lds + v_rd_base(lane);
  bf16x8 vs0, vs1, ks0, ks1;
#define SLOAD(k0) do { vs0 = *reinterpret_cast<const bf16x8*>(&Vh[(long)((k0) + sr) * LDK + sc]); vs1 = *reinterpret_cast<const bf16x8*>(&Vh[(long)((k0) + 32 + sr) * LDK + sc]); \
    ks0 = *reinterpret_cast<const bf16x8*>(&Kh[(long)((k0) + sr) * LDK + sc]); ks1 = *reinterpret_cast<const bf16x8*>(&Kh[(long)((k0) + 32 + sr) * LDK + sc]); } while (0)
#define SWRITE(slotB) do { *(bf16x8*)((char*)V_lds + (slotB) + vst0) = vs0; *(bf16x8*)((char*)V_lds + (slotB) + vst1) = vs1; const int kc = sc * 2;               \
    *(bf16x8*)((char*)K_lds + (slotB) + KSWZ(sr, kc)) = ks0; *(bf16x8*)((char*)K_lds + (slotB) + KSWZ(32 + sr, kc)) = ks1; } while (0)
  static_assert(SHM_V == SHM_K, "one slot offset serves both rings");
  f32x16 pA0, pA1, pB0, pB1; bf16x8 pa0, pa1, pa2, pa3; const int NT = seq / KVBLK;
  int s_prev = 0, s_cur = 0, s_next = (int)SHM_V;
#define ROT() do { s_prev = s_cur; s_cur = s_next; s_next = (s_next == 2 * (int)SHM_V) ? 0 : s_next + (int)SHM_V; } while (0)
#define STEP(PN0, PN1, PP0, PP1, jj) do { \
    SBAR(); qkt(PN0, PN1, (bf16*)((char*)K_lds + s_cur), qr, r32, hi); \
    finishSM(PP0, PP1, l_reg, pa0, pa1, pa2, pa3); SBAR(); \
    if ((jj) + 1 < NT) { SWRITE(s_next); } if ((jj) + 2 < NT) SLOAD(((jj) + 2) * KVBLK); SBAR(); \
    pv_d0(o, vb0 + s_prev, pa0, pa1, pa2, pa3); partialSM(PN0, PN1); \
    __syncthreads(); ROT(); } while (0)
  SLOAD(0); SWRITE(0); if (1 < NT) SLOAD(KVBLK); __syncthreads();
  qkt(pA0, pA1, K_lds, qr, r32, hi); partialSM(pA0, pA1);
  if (1 < NT) { SWRITE(s_next); } if (2 < NT) SLOAD(2 * KVBLK);
  __syncthreads(); ROT();
  int j = 1;
  for (; j + 1 < NT; j += 2) { STEP(pB0, pB1, pA0, pA1, j); STEP(pA0, pA1, pB0, pB1, j + 1); }
  SBAR(); qkt(pB0, pB1, (bf16*)((char*)K_lds + s_cur), qr, r32, hi);
  finishSM(pA0, pA1, l_reg, pa0, pa1, pa2, pa3); SBAR();
  pv_d0(o, vb0 + s_prev, pa0, pa1, pa2, pa3); partialSM(pB0, pB1);
  finishSM(pB0, pB1, l_reg, pa0, pa1, pa2, pa3); SBAR();
  pv_d0(o, vb0 + s_cur, pa0, pa1, pa2, pa3);
  if (hi == 0) li_l[r32] = l_reg; asm volatile("s_waitcnt lgkmcnt(0)" ::: "memory");
  float rli[16];
#pragma unroll
  for (int r = 0; r < 16; ++r) rli[r] = __builtin_amdgcn_rcpf(li_l[crow(r, hi)]);
  bf16* Ow = Ob + (long)(wid * QBLK) * LDO;
#pragma unroll
  for (int r = 0; r < 16; ++r) { int orow = crow(r, hi);
    for (int d0 = 0; d0 < 4; ++d0) { const float v = o[d0][r] * rli[r]; Ow[(long)orow * LDO + d0 * 32 + r32] = (bf16)(cvtpk(v, v) & 0xffffu); } }
  __syncthreads();
#undef SLOAD
#undef SWRITE
#undef ROT
#undef STEP
}
#undef KSWZ
#undef SBAR
}

constexpr int DM = 2048, SEQ = 8192, LCTX = 256, MROWS = SEQ + LCTX  , NLAYER = 4;
constexpr int INW = 6656, FF = 5632, FF2 = 2 * FF, HGW = 1024, PHW = 5120;
constexpr int NTILE = MROWS / 256;
constexpr float EPS = 1e-6f;

constexpr size_t MiB = 1u << 20;
constexpr size_t WS_CTL = 0, CTL_ZERO_BYTES = 1 * MiB;
constexpr size_t WS_MOD = 1 * MiB;
constexpr size_t WS_LB = WS_MOD + 512 * 1024;
constexpr size_t WS_AG = WS_LB + 64 * 1024;
constexpr size_t WS_WIN = 2 * MiB;
constexpr size_t WS_WOUT = WS_WIN + (size_t)NLAYER * INW * DM * 2;
constexpr size_t WS_WUP = WS_WOUT + (size_t)NLAYER * DM * DM * 2;
constexpr size_t WS_WDN = WS_WUP + (size_t)NLAYER * FF2 * DM * 2;
constexpr size_t WS_X = WS_WDN + (size_t)NLAYER * DM * FF * 2;
constexpr size_t WS_H = WS_X + (size_t)MROWS * DM * 4;
constexpr size_t WS_QA = WS_H + (size_t)MROWS * DM * 2;
constexpr size_t WS_KA = WS_QA + (size_t)MROWS * 1024 * 2;
constexpr size_t WS_VA = WS_KA + (size_t)MROWS * 256 * 2;
constexpr size_t WS_PH = WS_VA + (size_t)MROWS * 256 * 2;
constexpr size_t WS_MIX = WS_PH + (size_t)MROWS * PHW * 4;
constexpr size_t WS_OF = WS_MIX + (size_t)MROWS * DM * 2;
constexpr size_t WS_OB = WS_OF + (size_t)MROWS * HGW * 4;
constexpr size_t WS_U = WS_OB + (size_t)MROWS * HGW * 4;
constexpr size_t WS_SS = WS_U + (size_t)16 * 33 * 16384 * 4;
constexpr size_t WS_HALO = WS_SS + (size_t)16 * 33 * 16384 * 4;
constexpr size_t WS_ACT = WS_HALO + (size_t)NTILE * 6 * FF * 4;
constexpr int NSPLIT_O = 16, NSPLIT_D = 22;
constexpr size_t WS_PARTO = WS_ACT + (size_t)MROWS * FF * 2;
constexpr size_t WS_PARTD = WS_PARTO + (size_t)NSPLIT_O * 256 * DM * 4;
constexpr size_t WS_END = WS_PARTD + (size_t)NSPLIT_D * 256 * DM * 4;

constexpr int CW_BAR = 4096;

constexpr int RING_BYTES = 131072, LDSX_OFF = RING_BYTES, MISC_OFF = RING_BYTES + 12288, LDS_BYTES = 147456;

#define GAS __attribute__((address_space(1)))
#define LAS __attribute__((address_space(3)))
typedef unsigned short bf16;
typedef unsigned v4u __attribute__((ext_vector_type(4)));
typedef unsigned v2u __attribute__((ext_vector_type(2)));
typedef float f32x4 __attribute__((ext_vector_type(4)));
typedef short bf16x8 __attribute__((ext_vector_type(8)));
typedef short s16x4 __attribute__((ext_vector_type(4)));
#define LDS_WAIT() asm volatile("s_waitcnt lgkmcnt(0)" ::: "memory")
#define VM_WAIT() asm volatile("s_waitcnt vmcnt(0)" ::: "memory")
__device__ __forceinline__ unsigned f2bf(float f) { unsigned u = __builtin_bit_cast(unsigned, f); return (u + 0x7fffu + ((u >> 16) & 1u)) >> 16; }
typedef float f32x2_t __attribute__((ext_vector_type(2))); typedef __bf16 bf16x2_t __attribute__((ext_vector_type(2)));
__device__ __forceinline__ unsigned pk2(float lo, float hi) { f32x2_t v = {lo, hi}; bf16x2_t b = __builtin_convertvector(v, bf16x2_t); return __builtin_bit_cast(unsigned, b); }
__device__ __forceinline__ float silu(float x) { return x / (1.f + __expf(-x)); }

#define XB_TMO      128
#define XB_XCNT(j)  (256  + 64 * (j))
#define XB_XSUB(j)  (1280 + 64 * (j))
#define XB_XGEN(j)  (2304 + 64 * (j))
#define XB_TOP      3328
#define XB_TOPGEN   3392
#define XCD_BAR_WORDS 3456
#define XB_SPIN_CAP (1u << 18)
__device__ __forceinline__ unsigned xb_ld(unsigned* p)              { return __hip_atomic_load(p, __ATOMIC_RELAXED, __HIP_MEMORY_SCOPE_AGENT); }
__device__ __forceinline__ unsigned xb_add(unsigned* p, unsigned v) { return __hip_atomic_fetch_add(p, v, __ATOMIC_RELAXED, __HIP_MEMORY_SCOPE_AGENT); }
__device__ __forceinline__ unsigned xb_xcc_id() { return (unsigned)__builtin_amdgcn_s_getreg((3 << 11) | 20) & 0xFu; }
#define XB_SPIN(cond, bar) do { unsigned _sp = 0; while (cond) { __builtin_amdgcn_s_sleep(1); \
    if ((++_sp & 255u) == 0u) { if (xb_ld(&(bar)[XB_TMO])) break; if (_sp > XB_SPIN_CAP) { atomicAdd(&(bar)[XB_TMO], 1u); break; } } } } while (0)
struct XcdBarrier { unsigned* bar; unsigned x; volatile LAS unsigned* st; };
__device__ __forceinline__ XcdBarrier xcd_barrier_post(unsigned* bar, volatile LAS unsigned* st) {
    XcdBarrier b; b.bar = bar; b.x = xb_xcc_id(); b.st = st;
    if (threadIdx.x == 0) (void)xb_add(&bar[XB_XCNT(b.x)], 1u);
    return b;
}
__device__ __forceinline__ void xcd_barrier_complete(unsigned* bar, unsigned x, unsigned& nloc, unsigned& nx) {
    const unsigned G = gridDim.x * gridDim.y * gridDim.z;
    unsigned sum, cnt, mine, sp = 0u;
    for (;;) {
        sum = 0u; cnt = 0u; mine = 0u;
#pragma unroll
        for (unsigned j = 0; j < 16; ++j) { const unsigned c = xb_ld(&bar[XB_XCNT(j)]); sum += c; cnt += (c > 0u) ? 1u : 0u; mine = (j == x) ? c : mine; }
        if (sum == G) break;
        __builtin_amdgcn_s_sleep(1);
        if ((++sp & 255u) == 0u) { if (xb_ld(&bar[XB_TMO])) break; if (sp > XB_SPIN_CAP) { atomicAdd(&bar[XB_TMO], 1u); break; } }
    }
    nloc = mine > 0u ? mine : 1u; nx = cnt > 0u ? cnt : 1u;
}
__device__ __forceinline__ void xcd_barrier(const XcdBarrier& b) {
    asm volatile("s_waitcnt vmcnt(0)" ::: "memory");
    __syncthreads();
    if (threadIdx.x == 0) {
        unsigned* bar = b.bar;
        __builtin_amdgcn_s_waitcnt(0);
        unsigned nloc = b.st[0], nx = b.st[1];
        if (nloc == 0u) { xcd_barrier_complete(bar, b.x, nloc, nx); b.st[0] = nloc; b.st[1] = nx; }
        const unsigned old = xb_add(&bar[XB_XSUB(b.x)], 1u);
        const unsigned gen = old / nloc;
        if (old + 1u == (gen + 1u) * nloc) {
            __builtin_amdgcn_fence(__ATOMIC_RELEASE, "agent");
            asm volatile("s_waitcnt vmcnt(0)" ::: "memory");
            const unsigned og = xb_add(&bar[XB_TOP], 1u);
            const unsigned tg = og / nx;
            if (og + 1u == (tg + 1u) * nx) xb_add(&bar[XB_TOPGEN], 1u);
            else XB_SPIN(xb_ld(&bar[XB_TOPGEN]) == tg, bar);
            __builtin_amdgcn_fence(__ATOMIC_ACQUIRE, "agent");
            xb_add(&bar[XB_XGEN(b.x)], 1u);
            asm volatile("s_waitcnt vmcnt(0)" ::: "memory");
        } else {
            XB_SPIN(xb_ld(&bar[XB_XGEN(b.x)]) == gen, bar);
            __builtin_amdgcn_fence(__ATOMIC_ACQUIRE, "agent");
            asm volatile("s_waitcnt vmcnt(0)" ::: "memory");
        }
    }
    __syncthreads();
}

__device__ __attribute__((noinline)) void xcd_barrier_call(unsigned* barp, unsigned x, volatile LAS unsigned* st) { XcdBarrier b; b.bar = barp; b.x = x; b.st = st; xcd_barrier(b); }

__device__ __forceinline__ float wave_sum(float v) {
#pragma unroll
    for (int o = 1; o < 64; o <<= 1) v += __shfl_xor(v, o);
    return v;
}
__device__ __forceinline__ int rowmap(int mode, int n) {
    if (mode == 1) { if (n >= 1280) return n; const int hb = n & ~127, d = n & 127, f = d & 31;
        return hb + 64 * (d >> 6) + 32 * (f >> 4) + 8 * ((f >> 2) & 3) + 4 * ((d >> 5) & 1) + (d & 3); }
    if (mode == 2) { if (n < FF) return (n >> 7) * 256 + (n & 127); const int c = n - FF; return (c >> 7) * 256 + 128 + (c & 127); }
    return n;
}
__device__ __forceinline__ void transpose_item(const float* W, int K, int N, bf16* WT, int mode, LAS float* scr, int item, int lane) {
    const int nblk = N / 32, kb = item / nblk, nb = item % nblk, k0 = 64 * kb, n0 = 32 * nb;
    { const int kr = lane >> 3, c4 = (lane & 7) * 4; f32x4 v[8];
#pragma unroll
    for (int i = 0; i < 8; ++i) v[i] = *(const f32x4*)(W + (size_t)(k0 + kr + 8 * i) * N + n0 + c4);
#pragma unroll
    for (int i = 0; i < 8; ++i) { LAS float* d = scr + (kr + 8 * i) * 33 + c4; d[0] = v[i][0]; d[1] = v[i][1]; d[2] = v[i][2]; d[3] = v[i][3]; } }
    LDS_WAIT(); asm volatile("" ::: "memory");
    const int c = lane & 7;
#pragma unroll
    for (int j = 0; j < 4; ++j) { const int n = (lane >> 3) + 8 * j; const LAS float* s = scr + (8 * c) * 33 + n;
        v4u o; o.x = pk2(s[0 * 33], s[1 * 33]); o.y = pk2(s[2 * 33], s[3 * 33]); o.z = pk2(s[4 * 33], s[5 * 33]); o.w = pk2(s[6 * 33], s[7 * 33]);
        *(v4u*)(WT + (size_t)rowmap(mode, n0 + n) * K + k0 + 8 * c) = o; }
    LDS_WAIT(); asm volatile("" ::: "memory");
}
__device__ __forceinline__ void norm_mod_row(const float* xin, float* xrow, const float* w, const float* sh, const float* sc, bf16* orow, int lane, const float* prow, int nsplit, const float* gate) {
    const f32x4* xr = (const f32x4*)xin + lane; f32x4 v[8]; float s = 0.f;
#pragma unroll
    for (int j = 0; j < 8; ++j) v[j] = xr[64 * j];
    if (prow) {
        f32x4 a[8];
#pragma unroll
        for (int j = 0; j < 8; ++j) a[j] = (f32x4){0.f, 0.f, 0.f, 0.f};
        for (int sp = 0; sp < nsplit; ++sp) {
#pragma unroll
            for (int j = 0; j < 8; ++j) a[j] += ((const f32x4*)(prow + (size_t)sp * 256 * DM))[lane + 64 * j]; }
#pragma unroll
        for (int j = 0; j < 8; ++j) { v[j] += a[j] * ((const f32x4*)gate)[lane + 64 * j]; ((f32x4*)xrow)[lane + 64 * j] = v[j]; }
    }
#pragma unroll
    for (int j = 0; j < 8; ++j) s += (v[j][0] * v[j][0] + v[j][1] * v[j][1]) + (v[j][2] * v[j][2] + v[j][3] * v[j][3]);
    const float rstd = rsqrtf(wave_sum(s) * (1.f / DM) + EPS);
    v2u* o8 = (v2u*)orow + lane;
#pragma unroll
    for (int j = 0; j < 8; ++j) { const f32x4 wv = ((const f32x4*)w)[lane + 64 * j], shv = ((const f32x4*)sh)[lane + 64 * j], scv = ((const f32x4*)sc)[lane + 64 * j];
        const f32x4 y = v[j] * rstd * wv * (scv + 1.f) + shv; v2u o; o.x = pk2(y[0], y[1]); o.y = pk2(y[2], y[3]); o8[64 * j] = o; }
}

__device__ __forceinline__ void norm_mod_row_wg(const float* xin, float* xrow, const float* w, const float* sh, const float* sc, bf16* orow, int lane, int wave, LAS float* red, const float* prow, int nsplit, const float* gate) {
    const int i4 = lane + 64 * wave;
    f32x4 v = ((const f32x4*)xin)[i4];
    if (prow) { f32x4 a = {0.f, 0.f, 0.f, 0.f};
#pragma unroll 8
        for (int sp = 0; sp < nsplit; ++sp) a += ((const f32x4*)(prow + (size_t)sp * 256 * DM))[i4];
        v += a * ((const f32x4*)gate)[i4]; ((f32x4*)xrow)[i4] = v; }
    const float s = wave_sum((v[0] * v[0] + v[1] * v[1]) + (v[2] * v[2] + v[3] * v[3]));
    __syncthreads();
    if (lane == 0) red[wave] = s;
    __syncthreads();
    float tot = 0.f;
#pragma unroll
    for (int q = 0; q < 8; ++q) tot += red[q];
    const float rstd = rsqrtf(tot * (1.f / DM) + EPS);
    const f32x4 wv = ((const f32x4*)w)[i4], shv = ((const f32x4*)sh)[i4], scv = ((const f32x4*)sc)[i4];
    const f32x4 y = v * rstd * wv * (scv + 1.f) + shv; v2u o; o.x = pk2(y[0], y[1]); o.y = pk2(y[2], y[3]); ((v2u*)orow)[i4] = o;
}

__device__ __forceinline__ float dpp_add(float v, float src_shifted) { return v + src_shifted; }
#define ROW_SHR_ADD(v, n) ((v) + __builtin_bit_cast(float, __builtin_amdgcn_update_dpp(0, __builtin_bit_cast(int, (v)), 0x110 + (n), 0xf, 0xf, false)))

constexpr int HG_QT = 0, HG_KT = 17408, HG_KH = 34816, HG_VT = 53248, HG_ET = 71680, HG_PQ = 272, HG_PS = 144;
constexpr int HG_SSQ = 73728;
template <int MODE>
__device__ __forceinline__ void hg_unit(LAS unsigned char* lds, const float* __restrict__ PH, const float* __restrict__ LBl  ,
                                        float* __restrict__ Ubuf, float* __restrict__ AG, const float* __restrict__ SS, float* __restrict__ OX, int h, int dir, int T,
                                        const float* __restrict__ OFr = nullptr, bf16* __restrict__ MIXo = nullptr, const float* __restrict__ hgw = nullptr) {
    constexpr bool OUT = MODE != 0, SUM = (MODE == 0 || MODE == 2), FUSE = MODE == 3;
    int tid = threadIdx.x; asm volatile("" : "+v"(tid));
    const int lane = tid & 63, w = __builtin_amdgcn_readfirstlane(tid >> 6), l15 = lane & 15, g = lane >> 4;
    const int hd = dir * 8 + h, grp = (dir == 0 || T == 0) ? T : (NTILE - T), col0 = 16 * w;
    f32x4 lbv[4];
#pragma unroll
    for (int k = 0; k < 4; ++k) lbv[k] = *(const f32x4*)(LBl + h * 128 + col0 + 4 * k);
    f32x4 S[8];
    if (MODE == 1 || MODE == 3) { const float* sp = SS + (size_t)(hd * NTILE + grp) * 16384 + col0 + l15;
#pragma unroll
        for (int t8 = 0; t8 < 8; ++t8)
#pragma unroll
            for (int r = 0; r < 4; ++r) S[t8][r] = sp[(16 * t8 + 4 * g + r) * 128]; }
    else {
#pragma unroll
        for (int t8 = 0; t8 < 8; ++t8) S[t8] = (f32x4){0.f, 0.f, 0.f, 0.f}; }
    float aprod = 1.f;
    LAS unsigned char* VTw = lds + HG_VT + w * 2304;
    LAS float* ET = (LAS float*)(lds + HG_ET);
    f32x4 qv[4], xv[4], vv[4];
    const int rstep = (dir == 0) ? 64 : -64;
    const float* pr = PH + (size_t)((dir == 0) ? (T * 256 + lane) : (T * 256 + 255 - lane)) * PHW + h * 128 + col0;
#define HG_LOAD() do { _Pragma("unroll") for (int k = 0; k < 4; ++k) { if (OUT) qv[k] = *(const f32x4*)(pr + 4 * k); xv[k] = *(const f32x4*)(pr + 1024 * (1 + dir) + 4 * k); vv[k] = *(const f32x4*)(pr + 3072 + 4 * k); } } while (0)
    HG_LOAD();
    f32x4 otot[4], ofv[4], gtv[4]; float hwv = 0.f;
    if (FUSE) hwv = hgw[col0 + l15];
    LAS float* SSQ = (LAS float*)(lds + HG_SSQ);
#define HG_FINISH(cc) do { _Pragma("unroll") for (int j = 0; j < 4; ++j) { f32x4 ss4 = {0.f, 0.f, 0.f, 0.f}; \
        _Pragma("unroll") for (int w2 = 0; w2 < 8; ++w2) ss4 += *(const LAS f32x4*)(SSQ + w2 * 64 + 16 * j + 4 * g); \
        _Pragma("unroll") for (int rr = 0; rr < 4; ++rr) { const float rstd = rsqrtf(ss4[rr] * (1.f / 128.f) + EPS); const float y = otot[j][rr] * rstd * hwv * silu(gtv[j][rr]); \
            const int orow = T * 256 + 255 - ((cc) * 64 + 16 * j + 4 * g + rr); MIXo[(size_t)orow * DM + 1024 + h * 128 + col0 + l15] = (bf16)(pk2(y, y) & 0xffffu); } } } while (0)
    for (int c = 0; c < 4; ++c) {
        if (c > 0) __syncthreads();
        if (FUSE && c > 0) HG_FINISH(c - 1);
        unsigned qt[8], kt[8];
        f32x4 etv[4];
#pragma unroll
        for (int k = 0; k < 4; ++k) {
            float qe[4], ke[4];
#pragma unroll
            for (int e = 0; e < 4; ++e) {
                const float x = xv[k][e], lb = lbv[k][e];
                const float sg = __builtin_amdgcn_rcpf(1.f + __expf(-x));
                const float fg = lb + (1.f - lb) * sg;
                const float kk = 1.f - fg;
                float gl = fmaxf(__logf(fg), -80.f);
                float lc = gl; lc = ROW_SHR_ADD(lc, 1); lc = ROW_SHR_ADD(lc, 2); lc = ROW_SHR_ADD(lc, 4); lc = ROW_SHR_ADD(lc, 8);
                const float elc = __expf(lc);
                const float tot = __shfl(lc, lane | 15);
                etv[k][e] = elc;
                const float kh = kk * __expf(tot - lc);
                const unsigned kv2 = pk2(kh, vv[k][e]);
                *(LAS bf16*)(lds + HG_KH + (col0 + 4 * k + e) * HG_PS + lane * 2) = (bf16)(kv2 & 0xffffu);
                *(LAS bf16*)(VTw + (4 * k + e) * HG_PS + lane * 2) = (bf16)(kv2 >> 16);
                if (OUT) { qe[e] = qv[k][e] * elc; ke[e] = kk * __builtin_amdgcn_rcpf(fmaxf(elc, 8.7565e-27f)); }
            }
            if (OUT) { qt[2 * k] = pk2(qe[0], qe[1]); qt[2 * k + 1] = pk2(qe[2], qe[3]); kt[2 * k] = pk2(ke[0], ke[1]); kt[2 * k + 1] = pk2(ke[2], ke[3]); }
        }
        if (OUT) {
            *(LAS v4u*)(lds + HG_QT + lane * HG_PQ + col0 * 2) = (v4u){qt[0], qt[1], qt[2], qt[3]}; *(LAS v4u*)(lds + HG_QT + lane * HG_PQ + col0 * 2 + 16) = (v4u){qt[4], qt[5], qt[6], qt[7]};
            *(LAS v4u*)(lds + HG_KT + lane * HG_PQ + col0 * 2) = (v4u){kt[0], kt[1], kt[2], kt[3]}; *(LAS v4u*)(lds + HG_KT + lane * HG_PQ + col0 * 2 + 16) = (v4u){kt[4], kt[5], kt[6], kt[7]};
        }
        if (l15 == 15) {
#pragma unroll
            for (int k = 0; k < 4; ++k) *(LAS f32x4*)(ET + g * 128 + col0 + 4 * k) = etv[k]; }
        if (c < 3) { pr += (ptrdiff_t)rstep * PHW; HG_LOAD(); }
        __syncthreads();
        if (FUSE) {
#pragma unroll
            for (int j = 0; j < 4; ++j)
#pragma unroll
                for (int rr = 0; rr < 4; ++rr) { const size_t orow = (size_t)(T * 256 + 255 - (c * 64 + 16 * j + 4 * g + rr));
                    ofv[j][rr] = OFr[orow * HGW + h * 128 + col0 + l15]; gtv[j][rr] = PH[orow * PHW + 4096 + h * 128 + col0 + l15]; } }
        if (SUM && tid < 128) aprod *= (ET[tid] * ET[128 + tid]) * (ET[256 + tid] * ET[384 + tid]);
#pragma unroll
        for (int j = 0; j < 4; ++j) {
            const v2u vfr = *(const LAS v2u*)(VTw + l15 * HG_PS + (16 * j + 4 * g) * 2);
            const s16x4 vf = __builtin_bit_cast(s16x4, vfr);
            if (OUT) {
                f32x4 o = {0.f, 0.f, 0.f, 0.f}, st = {0.f, 0.f, 0.f, 0.f};
#pragma unroll
                for (int kk = 0; kk < 4; ++kk) {
                    const LAS unsigned char* qp = lds + HG_QT + (16 * j + l15) * HG_PQ + (32 * kk + 4 * g) * 2;
                    const LAS unsigned char* kp = lds + HG_KT + (16 * j + l15) * HG_PQ + (32 * kk + 4 * g) * 2;
                    const v2u q0 = *(const LAS v2u*)qp, q1 = *(const LAS v2u*)(qp + 32), k0 = *(const LAS v2u*)kp, k1 = *(const LAS v2u*)(kp + 32);
                    const bf16x8 qf = __builtin_bit_cast(bf16x8, (v4u){q0.x, q0.y, q1.x, q1.y}), kf = __builtin_bit_cast(bf16x8, (v4u){k0.x, k0.y, k1.x, k1.y});
                    const bf16x8 sf = __builtin_bit_cast(bf16x8, (v4u){pk2(S[2 * kk][0], S[2 * kk][1]), pk2(S[2 * kk][2], S[2 * kk][3]), pk2(S[2 * kk + 1][0], S[2 * kk + 1][1]), pk2(S[2 * kk + 1][2], S[2 * kk + 1][3])});
                    o = __builtin_amdgcn_mfma_f32_16x16x32_bf16(qf, sf, o, 0, 0, 0);
                    st = __builtin_amdgcn_mfma_f32_16x16x32_bf16(kf, qf, st, 0, 0, 0);
                }
#pragma unroll
                for (int rr = 0; rr < 4; ++rr) if (4 * g + rr > l15) st[rr] = 0.f;
                const s16x4 pf = __builtin_bit_cast(s16x4, (v2u){pk2(st[0], st[1]), pk2(st[2], st[3])});
                const f32x4 oi = __builtin_amdgcn_mfma_f32_16x16x16bf16_1k(pf, vf, (f32x4){0.f, 0.f, 0.f, 0.f}, 0, 0, 0);
                o += oi;
                if (FUSE) otot[j] = o + ofv[j];
                else {
#pragma unroll
                for (int rr = 0; rr < 4; ++rr) { const int tt = c * 64 + 16 * j + 4 * g + rr; const int orow = (dir == 0) ? (T * 256 + tt) : (T * 256 + 255 - tt);
                    OX[(size_t)orow * HGW + h * 128 + col0 + l15] = o[rr]; } }
            }
#pragma unroll
            for (int t8 = 0; t8 < 8; ++t8) {
                const f32x4 ev = *(const LAS f32x4*)(ET + j * 128 + 16 * t8 + 4 * g);
                const v2u kh = *(const LAS v2u*)(lds + HG_KH + (16 * t8 + l15) * HG_PS + (16 * j + 4 * g) * 2);
                S[t8] = __builtin_amdgcn_mfma_f32_16x16x16bf16_1k(__builtin_bit_cast(s16x4, kh), vf, S[t8] * ev, 0, 0, 0);
            }
        }
        if (FUSE) {
#pragma unroll
            for (int j = 0; j < 4; ++j) { f32x4 q4 = otot[j] * otot[j];
#pragma unroll
                for (int rr = 0; rr < 4; ++rr) { float v = q4[rr]; v = ROW_SHR_ADD(v, 1); v = ROW_SHR_ADD(v, 2); v = ROW_SHR_ADD(v, 4); v = ROW_SHR_ADD(v, 8); q4[rr] = v; }
                if (l15 == 15) *(LAS f32x4*)(SSQ + w * 64 + 16 * j + 4 * g) = q4; } }
    }
#undef HG_LOAD
    if (SUM) {
        float* up = Ubuf + (size_t)(hd * NTILE + grp) * 16384 + col0 + l15;
#pragma unroll
        for (int t8 = 0; t8 < 8; ++t8)
#pragma unroll
            for (int r = 0; r < 4; ++r) up[(16 * t8 + 4 * g + r) * 128] = S[t8][r];
        if (tid < 128) AG[(hd * NTILE + grp) * 128 + tid] = aprod;
    }
    VM_WAIT();
    __syncthreads();
    if (FUSE) { HG_FINISH(3); __syncthreads(); }
#undef HG_FINISH
}

constexpr int NWAVES = 8;
enum { PH_PRO = 0, PH_NORM1 = 1, PH_INPROJ = 2, PH_ATTN = 3, PH_HG1 = 4, PH_HG2 = 5, PH_HG3 = 6, PH_HGOUT = 7, PH_OUTPROJ = 8, PH_NORM2 = 9, PH_UP = 10, PH_CONV = 11, PH_DOWN = 12, PH_FINAL = 13, PH_COUNT = 14 };
struct Args { const float* in[19]; float* out; unsigned char* ws; int ph_lo, ph_hi, l_lo, l_hi, use_bar, pad; };

__global__ void __launch_bounds__(NWAVES * 64, 2) fwd_kernel(Args args) {
    extern __shared__ __attribute__((aligned(16))) unsigned char lds_raw[];
    LAS unsigned char* lds = (LAS unsigned char*)lds_raw;
    volatile LAS unsigned* MISC = (volatile LAS unsigned*)(lds + MISC_OFF);
    const int G = gridDim.x; const int bx = blockIdx.x; const int vcu = (G % 8 == 0) ? (bx % 8) * (G / 8) + bx / 8 : bx;
    if (threadIdx.x < 64) MISC[threadIdx.x] = 0u;
    __syncthreads();
    XcdBarrier bar; bar.bar = (unsigned*)(args.ws + WS_CTL) + CW_BAR; bar.x = 0; bar.st = nullptr;
#if MK_ONE_LAUNCH
    bar = xcd_barrier_post((unsigned*)(args.ws + WS_CTL) + CW_BAR, MISC + 8);
#define GRID_BAR() xcd_barrier_call(bar.bar, bar.x, bar.st)
#define IN(k) true
#else
    const bool use_bar = args.use_bar != 0;
    if (use_bar) bar = xcd_barrier_post((unsigned*)(args.ws + WS_CTL) + CW_BAR, MISC + 8);
#define GRID_BAR() do { if (use_bar) xcd_barrier(bar); } while (0)
    const int lo = args.ph_lo, hi = args.ph_hi;
#define IN(k) (lo <= (k) && (k) < hi)
#endif
#define PHASE_BEGIN() size_t wsz_ = 0; asm volatile("" : "+s"(wsz_)); unsigned char* ws = args.ws + wsz_; int tid = threadIdx.x; asm volatile("" : "+v"(tid)); \
    const int lane = tid & 63, wave = __builtin_amdgcn_readfirstlane(tid >> 6); const int gw = vcu * NWAVES + wave, NGW = G * NWAVES; const int gt = vcu * (NWAVES * 64) + tid, NGT = G * NWAVES * 64; \
    (void)lane; (void)wave; (void)gw; (void)NGW; (void)gt; (void)NGT
#define WSP(T, off) ((T*)(ws + (off)))

    if (IN(PH_PRO)) {
        PHASE_BEGIN();
        const float* w_in = args.in[8]; const float* w_out = args.in[13]; const float* w_up = args.in[14]; const float* w_down = args.in[17];
        bf16* WIN = WSP(bf16, WS_WIN); bf16* WOUT = WSP(bf16, WS_WOUT); bf16* WUP = WSP(bf16, WS_WUP); bf16* WDN = WSP(bf16, WS_WDN);
        LAS float* scr = (LAS float*)(lds + wave * 16384);
        constexpr int I_IN = (DM / 64) * (INW / 32), I_OUT = (DM / 64) * (DM / 32), I_UP = (DM / 64) * (FF2 / 32), I_DN = (FF / 64) * (DM / 32), I_L = I_IN + I_OUT + I_UP + I_DN;
        for (int it = gw; it < NLAYER * I_L; it += NGW) {
            const int l = it / I_L; int r = it % I_L;
            if (r < I_IN) { transpose_item(w_in + (size_t)l * DM * INW, DM, INW, WIN + (size_t)l * INW * DM, 1, scr, r, lane); continue; } r -= I_IN;
            if (r < I_OUT) { transpose_item(w_out + (size_t)l * DM * DM, DM, DM, WOUT + (size_t)l * DM * DM, 0, scr, r, lane); continue; } r -= I_OUT;
            if (r < I_UP) { transpose_item(w_up + (size_t)l * DM * FF2, DM, FF2, WUP + (size_t)l * FF2 * DM, 2, scr, r, lane); continue; } r -= I_UP;
            transpose_item(w_down + (size_t)l * FF * DM, FF, DM, WDN + (size_t)l * DM * FF, 0, scr, r, lane);
        }
        { const float* hg_lb_logits = args.in[11]; float* LB = WSP(float, WS_LB);
        for (int i = gt; i < 2 * 1024; i += NGT) { const int d = i / 1024, k = i % 1024; float lg[4], mx = -1e30f;
#pragma unroll
            for (int l = 0; l < 4; ++l) { lg[l] = hg_lb_logits[(d * 4 + l) * 1024 + k]; mx = fmaxf(mx, lg[l]); }
            float den = 0.f;
#pragma unroll
            for (int l = 0; l < 4; ++l) { lg[l] = __expf(lg[l] - mx); den += lg[l]; }
            float cum = 0.f;
#pragma unroll
            for (int l = 0; l < 4; ++l) { const float sm = lg[l] / den; if (l > 0) cum += sm; LB[(d * 4 + l) * 1024 + k] = cum; } } }
        __syncthreads();
        { const float* in_c = args.in[1]; const float* in_cctx = args.in[3]; const float* w_mod = args.in[4]; const float* b_mod = args.in[5]; float* MOD = WSP(float, WS_MOD);
        LAS float* sv = (LAS float*)(lds + 0);
        LAS float* red = (LAS float*)(lds + 16384);
        for (int i = tid; i < 2 * DM; i += NWAVES * 64) { const float cv = (i < DM) ? in_c[i] : in_cctx[i - DM]; sv[i] = silu(cv); }
        __syncthreads();
        for (int it = vcu; it < NLAYER * 64; it += G) {
            const int l = it >> 6, c0 = (it & 63) * 192; const int kq = tid / 48, cq = tid % 48;
            f32x4 a0 = {0.f, 0.f, 0.f, 0.f}, a1 = {0.f, 0.f, 0.f, 0.f};
            if (tid < 480) { const float* wp = w_mod + (size_t)l * DM * 12288 + c0 + 4 * cq;
#pragma unroll 8
                for (int k = kq; k < DM; k += 10) { const f32x4 wv = *(const f32x4*)(wp + (size_t)k * 12288); a0 += wv * sv[k]; a1 += wv * sv[DM + k]; }
                *(LAS f32x4*)(red + (kq * 48 + cq) * 8) = a0; *(LAS f32x4*)(red + (kq * 48 + cq) * 8 + 4) = a1; }
            __syncthreads();
            if (tid < 384) { const int cq2 = tid >> 3, j = tid & 7; float sacc = 0.f;
#pragma unroll
                for (int q = 0; q < 10; ++q) sacc += red[(q * 48 + cq2) * 8 + j];
                const int which = j >> 2, col = c0 + 4 * cq2 + (j & 3);
                MOD[(l * 2 + which) * 12288 + col] = sacc + b_mod[l * 12288 + col]; }
            __syncthreads();
        } }
        GRID_BAR();
    }

#if MK_ONE_LAUNCH
    for (int l = 0; l < NLAYER; ++l) {
#else
    for (int l = args.l_lo; l < args.l_hi; ++l) {
#endif
        if (IN(PH_NORM1)) {
            PHASE_BEGIN();
            const float* modl = WSP(float, WS_MOD) + (size_t)(l * 2 + 0) * 12288; const float* modc = modl + 12288; float* X = WSP(float, WS_X); bf16* H = WSP(bf16, WS_H); const float* nw = args.in[6] + l * DM;
            const float* partd = WSP(float, WS_PARTD);
            for (int m = vcu; m < LCTX; m += G)
                norm_mod_row_wg(l > 0 ? X + (size_t)m * DM : args.in[2] + (size_t)m * DM, X + (size_t)m * DM, nw, modc, modc + DM, H + (size_t)m * DM, lane, wave, (LAS float*)lds, l > 0 ? partd + (size_t)m * DM : nullptr, NSPLIT_D, modc - 2 * 12288 + 5 * DM);
            for (int m = LCTX + gw; m < MROWS; m += NGW)
                norm_mod_row(l > 0 ? X + (size_t)m * DM : args.in[0] + (size_t)(m - LCTX) * DM, X + (size_t)m * DM, nw, modl, modl + DM, H + (size_t)m * DM, lane, nullptr, 0, nullptr);
            GRID_BAR();
        }
        if (IN(PH_INPROJ)) {
            PHASE_BEGIN();
            pg8::Gemm g{WSP(bf16, WS_H), WSP(bf16, WS_WIN) + (size_t)l * INW * DM, MROWS, INW, DM}; pg8::StaticOrder S; S.init(MROWS, INW, DM, G, bx);
            pg8::EpiInProj E{WSP(bf16, WS_QA), WSP(bf16, WS_KA), WSP(bf16, WS_VA), WSP(float, WS_PH), args.in[9] + l * 128, args.in[10] + l * 128};
            pg8::gemm_phase<pg8::EpiInProj, pg8::StaticOrder>(lds, lds + LDSX_OFF, g, S, E);
            GRID_BAR();
        }
        if (IN(PH_ATTN)) {
            PHASE_BEGIN();
            const bf16* QA = WSP(bf16, WS_QA); const bf16* KA = WSP(bf16, WS_KA); const bf16* VA = WSP(bf16, WS_VA); bf16* MIX = WSP(bf16, WS_MIX);
            for (int u = vcu; u < 256; u += G) { const long h = u >> 5, qb = u & 31;
                att::attn_dense_body(QA + ((LCTX + qb * 256) * 1024 + h * 128), KA + (h >> 2) * 128, VA + (h >> 2) * 128, MIX + ((LCTX + qb * 256) * 2048 + h * 128), MROWS, (char*)lds_raw);
                if (qb == 0) att::attn_dense_body(QA + h * 128, KA + (h >> 2) * 128, VA + (h >> 2) * 128, MIX + h * 128, LCTX, (char*)lds_raw);
            }
        }
        if (IN(PH_HG1)) {
            PHASE_BEGIN();
            for (int u = vcu; u < 16 * 32; u += G) { const int hd = u >> 5, grp = (hd < 8) ? (u & 31) : ((u + 16) & 31);
                const int dir = hd >> 3, h = hd & 7; const int T = (dir == 0 || grp == 0) ? grp : (NTILE - grp);
                if (grp == 0) hg_unit<2>(lds, WSP(float, WS_PH), WSP(float, WS_LB) + (dir * 4 + l) * 1024, WSP(float, WS_U), WSP(float, WS_AG), nullptr, dir == 0 ? WSP(float, WS_OF) : WSP(float, WS_OB), h, dir, 0);
                else hg_unit<0>(lds, WSP(float, WS_PH), WSP(float, WS_LB) + (dir * 4 + l) * 1024, WSP(float, WS_U), WSP(float, WS_AG), nullptr, nullptr, h, dir, T); }
            GRID_BAR();
        }
        if (IN(PH_HG2)) {
            PHASE_BEGIN();
            const float* UB = WSP(float, WS_U); const float* AG = WSP(float, WS_AG); float* SS = WSP(float, WS_SS);
            for (int e = gt; e < 16 * 16384; e += NGT) { const int hd = e >> 14, idx = e & 16383, dk = idx >> 7; float sacc = 0.f;
                const float* up = UB + (size_t)hd * NTILE * 16384 + idx; const float* ap = AG + hd * NTILE * 128 + dk; float* sp = SS + (size_t)hd * NTILE * 16384 + idx;
#pragma unroll 4
                for (int gI = 0; gI < NTILE; ++gI) { sp[(size_t)gI * 16384] = sacc; if (gI < NTILE - 1) sacc = ap[gI * 128] * sacc + up[(size_t)gI * 16384]; } }
            { const float* hw = args.in[12] + l * 128; const float* OF = WSP(float, WS_OF); const float* OB = WSP(float, WS_OB); const float* PH = WSP(float, WS_PH); bf16* MIX = WSP(bf16, WS_MIX);
            for (int m = gw; m < LCTX; m += NGW) {
#pragma unroll
                for (int p = 0; p < 4; ++p) { const int col = p * 256 + lane * 4; const int dv = (lane & 31) * 4;
                    const f32x4 a = *(const f32x4*)(OF + (size_t)m * HGW + col), b = *(const f32x4*)(OB + (size_t)m * HGW + col); const f32x4 o = a + b;
                    float sq = (o[0] * o[0] + o[1] * o[1]) + (o[2] * o[2] + o[3] * o[3]);
#pragma unroll
                    for (int sh = 1; sh < 32; sh <<= 1) sq += __shfl_xor(sq, sh);
                    const float rstd = rsqrtf(sq * (1.f / 128.f) + EPS);
                    const f32x4 wv = *(const f32x4*)(hw + dv), gt4 = *(const f32x4*)(PH + (size_t)m * PHW + 4096 + col);
                    f32x4 y = o * rstd * wv; y = (f32x4){y[0] * silu(gt4[0]), y[1] * silu(gt4[1]), y[2] * silu(gt4[2]), y[3] * silu(gt4[3])};
                    v2u w2; w2.x = pk2(y[0], y[1]); w2.y = pk2(y[2], y[3]); *(v2u*)(MIX + (size_t)m * DM + 1024 + col) = w2; } } }
            GRID_BAR();
        }
        if (IN(PH_HG3)) {
            PHASE_BEGIN();
            for (int u = vcu; u < 8 * 32; u += G) { const int h = u >> 5, T = 1 + (u & 31);
                hg_unit<1>(lds, WSP(float, WS_PH), WSP(float, WS_LB) + (0 * 4 + l) * 1024, nullptr, nullptr, WSP(float, WS_SS), WSP(float, WS_OF), h, 0, T);
                hg_unit<3>(lds, WSP(float, WS_PH), WSP(float, WS_LB) + (1 * 4 + l) * 1024, nullptr, nullptr, WSP(float, WS_SS), nullptr, h, 1, T, WSP(float, WS_OF), WSP(bf16, WS_MIX), args.in[12] + l * 128); }
            GRID_BAR();
        }
        if (IN(PH_OUTPROJ)) {
            PHASE_BEGIN();
            const float* modl = WSP(float, WS_MOD) + (size_t)(l * 2 + 0) * 12288;
            pg8::Gemm g{WSP(bf16, WS_MIX), WSP(bf16, WS_WOUT) + (size_t)l * DM * DM, MROWS, DM, DM}; pg8::ResidOrder S; S.init(DM, G, bx, l < NLAYER - 1, NSPLIT_O);
            pg8::EpiResid E{WSP(float, WS_X), l == 0 ? args.in[0] - (size_t)LCTX * DM : WSP(float, WS_X), modl + 2 * DM, WSP(float, WS_PARTO)};
            pg8::gemm_phase<pg8::EpiResid, pg8::ResidOrder>(lds, lds + LDSX_OFF, g, S, E);
            GRID_BAR();
        }
        if (IN(PH_NORM2)) {
            PHASE_BEGIN();
            const float* modl = WSP(float, WS_MOD) + (size_t)(l * 2 + 0) * 12288; const float* modc = modl + 12288; float* X = WSP(float, WS_X); bf16* H = WSP(bf16, WS_H); const float* nw = args.in[7] + l * DM;
            const float* parto = WSP(float, WS_PARTO);
            if (l < NLAYER - 1) for (int m = vcu; m < LCTX; m += G)
                norm_mod_row_wg(l == 0 ? args.in[2] + (size_t)m * DM : X + (size_t)m * DM, X + (size_t)m * DM, nw, modc + 3 * DM, modc + 4 * DM, H + (size_t)m * DM, lane, wave, (LAS float*)lds, parto + (size_t)m * DM, NSPLIT_O, modc + 2 * DM);
            for (int m = LCTX + gw; m < MROWS; m += NGW)
                norm_mod_row(X + (size_t)m * DM, X + (size_t)m * DM, nw, modl + 3 * DM, modl + 4 * DM, H + (size_t)m * DM, lane, nullptr, 0, nullptr);
            GRID_BAR();
        }
        if (IN(PH_UP)) {
            PHASE_BEGIN();
            pg8::Gemm g{WSP(bf16, WS_H), WSP(bf16, WS_WUP) + (size_t)l * FF2 * DM, MROWS, FF2, DM}; pg8::StaticOrder S;
            if (l < NLAYER - 1) S.init(MROWS, FF2, DM, G, bx); else S.init(SEQ, FF2, DM, G, bx, 1);
            pg8::EpiUpConv E{WSP(bf16, WS_ACT), WSP(float, WS_HALO), args.in[15] + (size_t)l * 3 * FF, args.in[16] + (size_t)l * FF};
            pg8::gemm_phase<pg8::EpiUpConv, pg8::StaticOrder>(lds, lds + LDSX_OFF, g, S, E);
            GRID_BAR();
        }
        if (IN(PH_CONV)) {
            PHASE_BEGIN();
            const float* cw = args.in[15] + (size_t)l * 3 * FF; const float* cb = args.in[16] + (size_t)l * FF; const float* HALO = WSP(float, WS_HALO); bf16* ACT = WSP(bf16, WS_ACT);
            for (int i = gt; i < 31 * 2 * (FF / 4); i += NGT) { const int c = (i % (FF / 4)) * 4, rb = i / (FF / 4), b = 1 + (rb >> 1), second = rb & 1;
                const float* ha = HALO + (size_t)b * 6 * FF + c; const float* hn = HALO + (size_t)(b + 1) * 6 * FF + c;
                const f32x4 w0 = *(const f32x4*)(cw + c), w1 = *(const f32x4*)(cw + FF + c), w2 = *(const f32x4*)(cw + 2 * FF + c), bb = *(const f32x4*)(cb + c);
                f32x4 gp, gc, gn, up; int row;
                if (!second) { gp = *(const f32x4*)(ha + 2 * FF); gc = *(const f32x4*)(ha + 3 * FF); gn = *(const f32x4*)(hn); up = *(const f32x4*)(ha + 5 * FF); row = 256 * b + 255; }
                else         { gp = *(const f32x4*)(ha + 3 * FF); gc = *(const f32x4*)(hn); gn = *(const f32x4*)(hn + FF); up = *(const f32x4*)(hn + 4 * FF); row = 256 * (b + 1); }
                const f32x4 z = gp * w0 + gc * w1 + gn * w2 + bb;
                v2u o; o.x = pk2(silu(z[0]) * up[0], silu(z[1]) * up[1]); o.y = pk2(silu(z[2]) * up[2], silu(z[3]) * up[3]);
                *(v2u*)(ACT + (size_t)row * FF + c) = o; }
            GRID_BAR();
        }
        if (IN(PH_DOWN)) {
            PHASE_BEGIN();
            const float* modl = WSP(float, WS_MOD) + (size_t)(l * 2 + 0) * 12288;
            pg8::Gemm g{WSP(bf16, WS_ACT), WSP(bf16, WS_WDN) + (size_t)l * DM * FF, MROWS, DM, FF}; pg8::ResidOrder S; S.init(FF, G, bx, l < NLAYER - 1, NSPLIT_D);
            pg8::EpiResid E{WSP(float, WS_X), WSP(float, WS_X), modl + 5 * DM, WSP(float, WS_PARTD)};
            pg8::gemm_phase<pg8::EpiResid, pg8::ResidOrder>(lds, lds + LDSX_OFF, g, S, E);
            GRID_BAR();
        }
    }
    if (IN(PH_FINAL)) {
        PHASE_BEGIN();
        const float* X = WSP(float, WS_X); const float* fw = args.in[18];
        for (int m = gw; m < SEQ; m += NGW) { const f32x4* xr = (const f32x4*)(X + (size_t)(LCTX + m) * DM) + lane; f32x4 v[8]; float sq = 0.f;
#pragma unroll
            for (int j = 0; j < 8; ++j) { v[j] = xr[64 * j]; sq += (v[j][0] * v[j][0] + v[j][1] * v[j][1]) + (v[j][2] * v[j][2] + v[j][3] * v[j][3]); }
            const float rstd = rsqrtf(wave_sum(sq) * (1.f / DM) + EPS);
            f32x4* o = (f32x4*)(args.out + (size_t)m * DM) + lane;
#pragma unroll
            for (int j = 0; j < 8; ++j) o[64 * j] = v[j] * rstd * ((const f32x4*)fw)[lane + 64 * j]; }
    }
#undef IN
#undef GRID_BAR
#undef PHASE_BEGIN
#undef WSP
}

extern "C" void kernel_launch(void* const* d_in, const int* in_sizes, int n_in, void* d_out, int out_size, void* d_ws, size_t ws_size, hipStream_t stream) {
    static int grid = 0;
    if (grid == 0) {
        if (n_in != 19 || in_sizes[0] != SEQ * DM || out_size != SEQ * DM || ws_size < WS_END) {
            fprintf(stderr, "kernel_launch: unexpected shapes: n_in %d in0 %d out %d ws %zu (need %zu)\n", n_in, n_in > 0 ? in_sizes[0] : -1, out_size, ws_size, (size_t)WS_END); grid = -1; return; }
        int dev = 0, cus = 0;
        if (hipGetDevice(&dev) != hipSuccess || hipDeviceGetAttribute(&cus, hipDeviceAttributeMultiprocessorCount, dev) != hipSuccess) { grid = -1; return; }
        if (hipFuncSetAttribute((const void*)fwd_kernel, hipFuncAttributeMaxDynamicSharedMemorySize, LDS_BYTES) != hipSuccess) { fprintf(stderr, "kernel_launch: hipFuncSetAttribute failed\n"); grid = -1; return; }
        int per_cu = 0;
        if (hipOccupancyMaxActiveBlocksPerMultiprocessor(&per_cu, (const void*)fwd_kernel, NWAVES * 64, LDS_BYTES) != hipSuccess || per_cu < 1) fprintf(stderr, "kernel_launch: occupancy query says %d\n", per_cu);
        (void)hipGetLastError();
        grid = cus;
    }
    if (grid < 0) return;
    (void)hipMemsetAsync((char*)d_ws + WS_CTL, 0, CTL_ZERO_BYTES, stream);
    Args a{};
    for (int i = 0; i < 19; ++i) a.in[i] = (const float*)d_in[i];
    a.out = (float*)d_out; a.ws = (unsigned char*)d_ws;
#if MK_ONE_LAUNCH
    a.ph_lo = 0; a.ph_hi = PH_COUNT; a.l_lo = 0; a.l_hi = NLAYER; a.use_bar = 1;
    hipLaunchKernelGGL(fwd_kernel, dim3(grid), dim3(NWAVES * 64), LDS_BYTES, stream, a);
#else
    a.use_bar = 0;
    a.ph_lo = PH_PRO; a.ph_hi = PH_PRO + 1; a.l_lo = 0; a.l_hi = 0;
    hipLaunchKernelGGL(fwd_kernel, dim3(grid), dim3(NWAVES * 64), LDS_BYTES, stream, a);
    for (int l = 0; l < NLAYER; ++l)
        for (int p = PH_NORM1; p <= PH_DOWN; ++p) { a.ph_lo = p; a.ph_hi = p + 1; a.l_lo = l; a.l_hi = l + 1;
            hipLaunchKernelGGL(fwd_kernel, dim3(grid), dim3(NWAVES * 64), LDS_BYTES, stream, a); }
    a.ph_lo = PH_FINAL; a.ph_hi = PH_FINAL + 1; a.l_lo = 0; a.l_hi = 0;
    hipLaunchKernelGGL(fwd_kernel, dim3(grid), dim3(NWAVES * 64), LDS_BYTES, stream, a);
#endif
    const hipError_t le = hipPeekAtLastError();
    if (le != hipSuccess) fprintf(stderr, "kernel_launch: launch failed: %s\n", hipGetErrorName(le));
}
```

```cpp
#include <hip/hip_runtime.h>
#include <cstdio>
#include <cstdint>

#ifndef MK_ONE_LAUNCH
#define MK_ONE_LAUNCH 1
#endif

namespace pg8 {
#define PG8_LAS __attribute__((address_space(3)))
typedef unsigned short bf16_t;
typedef short bf16x8 __attribute__((ext_vector_type(8)));
typedef float f32x4 __attribute__((ext_vector_type(4)));
typedef unsigned u32x4 __attribute__((ext_vector_type(4)));
constexpr int BM = 256, BK = 64, HALF = 128, HTB = HALF * BK * 2, STAGE_BYTES = 8 * HTB, NXCD = 8, WGM = 8;

__host__ __device__ __forceinline__ int lds_byte(int r, int c) { const int st = (r >> 4) * 2 + (c >> 5), rr = r & 15, cc = c & 31, ob = rr * 64 + cc * 2; return st * 1024 + (ob ^ (((ob >> 9) & 1) << 5)); }
__host__ __device__ __forceinline__ void stage_rc(int b, int& R, int& C) { const int st = b / 1024, sb = b % 1024, swz = sb ^ (((sb >> 9) & 1) << 5); R = (st >> 1) * 16 + swz / 64; C = (st & 1) * 32 + (swz % 64) / 2; }
__host__ __device__ __forceinline__ int perm32(int rho) { const int n = rho >> 4, i = rho & 15; return 8 * (i >> 2) + 4 * n + (i & 3); }

struct Unit { int pm, pn, kt0, nkt, part; };
struct Gemm { const bf16_t* A; const bf16_t* Bt; int M, N, K; };

struct StaticOrder {
    int nM, nN, nwg, G, c, nkt, pm0;
    __host__ __device__ void init(int M, int N, int K, int G_, int c_, int pm0_ = 0) { nM = M / BM; nN = N / BM; nwg = nM * nN; G = G_; c = c_; nkt = K / BK; pm0 = pm0_; }
    __host__ __device__ bool next(int i, Unit& u) const { return by_index((long)i * G + c, u); }
    __host__ __device__ bool by_index(long L, Unit& u) const {
        if (L >= nwg) return false;
        int wgid = (int)L; { const int q = nwg / NXCD, r = nwg % NXCD, xcd = wgid % NXCD, off = wgid / NXCD; wgid = (xcd < r ? xcd * (q + 1) : r * (q + 1) + (xcd - r) * q) + off; }
        const int nig = WGM * nN, gid = wgid / nig, fm = gid * WGM, gsz = (nM - fm) < WGM ? (nM - fm) : WGM;
        u.pm = pm0 + fm + ((wgid % nig) % gsz); u.pn = (wgid % nig) / gsz; u.kt0 = 0; u.nkt = nkt; u.part = -1; return true;
    }
    __device__ __forceinline__ void a_ready(const Unit&) const {}
    __device__ __forceinline__ void done(const Unit&) const {}
};

struct ResidOrder {
    int G, c, nkt, nsplit, skt, with_ctx;
    __host__ __device__ void init(int K, int G_, int c_, bool with_ctx_, int nsplit_) { G = G_; c = c_; nkt = K / BK; with_ctx = with_ctx_ ? 1 : 0; nsplit = nsplit_; skt = (K / BK) / nsplit_; }
    __host__ __device__ bool next(int i, Unit& u) const {
        const int L = i * G + c; const bool lat = L < 256; const int j = L - 256;
        if (!lat && (!with_ctx || j >= 8 * nsplit)) return false;
        const int wgid = (L & 7) * 32 + (L >> 3), r64 = wgid & 63;
        u.pm = lat ? 1 + (wgid >> 6) * 8 + (r64 & 7) : 0; u.pn = lat ? (r64 >> 3) : (j & 7); u.part = lat ? -1 : (j >> 3); u.kt0 = lat ? 0 : (j >> 3) * skt; u.nkt = lat ? nkt : skt; return true;
    }
    __device__ __forceinline__ void a_ready(const Unit&) const {}
    __device__ __forceinline__ void done(const Unit&) const {}
};

__device__ __forceinline__ unsigned cvt_pk_bf16(float lo, float hi) { unsigned r; asm volatile("v_cvt_pk_bf16_f32 %0, %1, %2" : "=v"(r) : "v"(lo), "v"(hi)); return r; }
__device__ __forceinline__ float silu_f(float x) { return x * __builtin_amdgcn_rcpf(1.f + __expf(-x)); }


struct EpiInProj {
    static constexpr bool PERM = true;
    bf16_t* QA; bf16_t* KA; bf16_t* VA; float* PH; const float* qw; const float* kw; bf16_t* HB;
    __device__ __forceinline__ void operator()(const f32x4 (&acc)[2][2][4][2], const Unit& u, int wr, int wc, int fr, int fq, PG8_LAS unsigned char* ldsx) const {
        const int row0 = u.pm * BM + wr * 64 + fr; const int pn = u.pn;
        if (pn >= 10 && pn < 18) {
            const int colb = (pn - 6) * 256 + wc * 32 + 8 * fq;
#pragma unroll
            for (int ai = 0; ai < 2; ++ai)
#pragma unroll
                for (int m = 0; m < 4; ++m) { float* rowp = PH + (size_t)(row0 + ai * HALF + m * 16) * 5120 + colb;
#pragma unroll
                    for (int bj = 0; bj < 2; ++bj) { *(f32x4*)(rowp + bj * HALF) = acc[ai][bj][m][0]; *(f32x4*)(rowp + bj * HALF + 4) = acc[ai][bj][m][1]; } }
        } else if (pn >= 6) {
            const bool act = pn < 10; const int colb = (pn < 10 ? (pn - 6) * 256 : pn < 22 ? 1024 + (pn - 18) * 256 : 2048 + (pn - 22) * 256) + wc * 32 + 8 * fq;
#pragma unroll
            for (int ai = 0; ai < 2; ++ai)
#pragma unroll
                for (int m = 0; m < 4; ++m) { bf16_t* rowp = HB + (size_t)(row0 + ai * HALF + m * 16) * 3072 + colb;
#pragma unroll
                    for (int bj = 0; bj < 2; ++bj) { f32x4 v0 = acc[ai][bj][m][0], v1 = acc[ai][bj][m][1];
                        if (act) { v0 = (f32x4){silu_f(v0[0]), silu_f(v0[1]), silu_f(v0[2]), silu_f(v0[3])}; v1 = (f32x4){silu_f(v1[0]), silu_f(v1[1]), silu_f(v1[2]), silu_f(v1[3])}; }
                        u32x4 w; w.x = cvt_pk_bf16(v0[0], v0[1]); w.y = cvt_pk_bf16(v0[2], v0[3]); w.z = cvt_pk_bf16(v1[0], v1[1]); w.w = cvt_pk_bf16(v1[2], v1[3]);
                        *(u32x4*)(rowp + bj * HALF) = w; } }
        } else if (pn == 5) {
            const int colb = wc * 32 + 8 * fq;
#pragma unroll
            for (int ai = 0; ai < 2; ++ai)
#pragma unroll
                for (int m = 0; m < 4; ++m) { bf16_t* rowp = VA + (size_t)(row0 + ai * HALF + m * 16) * 256 + colb;
#pragma unroll
                    for (int bj = 0; bj < 2; ++bj) { const f32x4 v0 = acc[ai][bj][m][0], v1 = acc[ai][bj][m][1]; u32x4 w;
                        w.x = cvt_pk_bf16(v0[0], v0[1]); w.y = cvt_pk_bf16(v0[2], v0[3]); w.z = cvt_pk_bf16(v1[0], v1[1]); w.w = cvt_pk_bf16(v1[2], v1[3]);
                        *(u32x4*)(rowp + bj * HALF) = w; } }
        } else {
            PG8_LAS float* P = (PG8_LAS float*)ldsx;
#pragma unroll
            for (int ai = 0; ai < 2; ++ai)
#pragma unroll
                for (int m = 0; m < 4; ++m)
#pragma unroll
                    for (int bj = 0; bj < 2; ++bj) { const f32x4 a = acc[ai][bj][m][0], b = acc[ai][bj][m][1];
                        float s = (a[0] * a[0] + a[1] * a[1]) + (a[2] * a[2] + a[3] * a[3]) + (b[0] * b[0] + b[1] * b[1]) + (b[2] * b[2] + b[3] * b[3]);
                        s += __shfl_xor(s, 16); s += __shfl_xor(s, 32);
                        if (fq == 0) P[((ai * HALF + wr * 64 + m * 16 + fr) * 2 + bj) * 4 + wc] = s; }
            asm volatile("s_waitcnt lgkmcnt(0)" ::: "memory"); __builtin_amdgcn_s_barrier(); asm volatile("" ::: "memory");
            const bool isq = pn < 4; const float* nw = isq ? qw : kw;
            const int dbase = (wc >> 1) * 64 + (wc & 1) * 16 + fq * 4;
            const f32x4 w0 = *(const f32x4*)(nw + dbase), w1 = *(const f32x4*)(nw + dbase + 32);
            float fr4[4];
#pragma unroll
            for (int e = 0; e < 4; ++e) fr4[e] = exp2f(-(float)((wc & 1) * 16 + fq * 4 + e) * (13.287712379549449f / 32.f));
            const bool rope = u.pm > 0;
#pragma unroll
            for (int ai = 0; ai < 2; ++ai)
#pragma unroll
                for (int m = 0; m < 4; ++m) { const int grow = row0 + ai * HALF + m * 16; const int t = grow - 256; const float pos = (float)((wc >> 1) ? (t & 63) : (t >> 6));
                    f32x4 cs, sn;
#pragma unroll
                    for (int e = 0; e < 4; ++e) { const float ang = pos * fr4[e]; cs[e] = rope ? __cosf(ang) : 1.f; sn[e] = rope ? __sinf(ang) : 0.f; }
#pragma unroll
                    for (int bj = 0; bj < 2; ++bj) { const f32x4 p = *(const PG8_LAS f32x4*)(P + ((ai * HALF + wr * 64 + m * 16 + fr) * 2 + bj) * 4);
                        const float rstd = rsqrtf(((p[0] + p[1]) + (p[2] + p[3])) * (1.f / 128.f) + 1e-6f) * (isq ? 0.12751743074602468f : 1.f);
                        const f32x4 x1 = acc[ai][bj][m][0] * rstd * w0, x2 = acc[ai][bj][m][1] * rstd * w1;
                        const f32x4 o1 = x1 * cs - x2 * sn, o2 = x2 * cs + x1 * sn; u32x4 w;
                        w.x = cvt_pk_bf16(o1[0], o1[1]); w.y = cvt_pk_bf16(o1[2], o1[3]); w.z = cvt_pk_bf16(o2[0], o2[1]); w.w = cvt_pk_bf16(o2[2], o2[3]);
                        bf16_t* dst = isq ? QA + (size_t)grow * 1024 + (2 * pn + bj) * 128 + wc * 32 + 8 * fq : KA + (size_t)grow * 256 + bj * 128 + wc * 32 + 8 * fq;
                        *(u32x4*)dst = w; } }
        }
    }
};
struct EpiResid {
    static constexpr bool PERM = false;
    float* X; const float* Xin; const float* gl; float* PART;
    __device__ __forceinline__ void operator()(const f32x4 (&acc)[2][2][4][2], const Unit& u, int wr, int wc, int fr, int fq, PG8_LAS unsigned char*) const {
        const int row0 = u.pm * BM + wr * 64 + fr, col0 = u.pn * BM + wc * 32 + 4 * fq; const float* g = gl;
        if (u.part >= 0) {
#pragma unroll
            for (int ai = 0; ai < 2; ++ai)
#pragma unroll
                for (int m = 0; m < 4; ++m) { float* rowp = PART + ((size_t)u.part * 256 + (wr * 64 + fr + ai * HALF + m * 16)) * 2048 + col0;
#pragma unroll
                    for (int bj = 0; bj < 2; ++bj)
#pragma unroll
                        for (int n = 0; n < 2; ++n) *(f32x4*)(rowp + bj * HALF + n * 16) = acc[ai][bj][m][n]; }
            return;
        }
        f32x4 gv[2][2];
#pragma unroll
        for (int bj = 0; bj < 2; ++bj)
#pragma unroll
            for (int n = 0; n < 2; ++n) gv[bj][n] = *(const f32x4*)(g + col0 + bj * HALF + n * 16);
#pragma unroll
        for (int ai = 0; ai < 2; ++ai)
#pragma unroll
            for (int m = 0; m < 4; ++m) { float* rowp = X + (size_t)(row0 + ai * HALF + m * 16) * 2048 + col0; const float* rinp = Xin + (size_t)(row0 + ai * HALF + m * 16) * 2048 + col0;
#pragma unroll
                for (int bj = 0; bj < 2; ++bj)
#pragma unroll
                    for (int n = 0; n < 2; ++n) { f32x4* p = (f32x4*)(rowp + bj * HALF + n * 16); *p = *(const f32x4*)(rinp + bj * HALF + n * 16) + gv[bj][n] * acc[ai][bj][m][n]; } }
    }
};
template <int CTRL> __device__ __forceinline__ float dppf(float v) { return __int_as_float(__builtin_amdgcn_update_dpp(0, __float_as_int(v), CTRL, 0xf, 0xf, false)); }
struct EpiUpConv {
    static constexpr bool PERM = true;
    bf16_t* ACT; float* HALO; const float* cw; const float* cb;
    __device__ __forceinline__ void operator()(const f32x4 (&acc)[2][2][4][2], const Unit& u, int wr, int wc, int fr, int fq, PG8_LAS unsigned char* ldsx) const {
        PG8_LAS float* EDGE = (PG8_LAS float*)ldsx;
        const int cg = wc * 32 + 8 * fq, ff = u.pn * 128 + cg;
        if (fr == 0) {
#pragma unroll
            for (int ai = 0; ai < 2; ++ai)
#pragma unroll
                for (int n = 0; n < 2; ++n) *(PG8_LAS f32x4*)(EDGE + ((2 * ai + wr) * 2 + 0) * 128 + cg + 4 * n) = acc[ai][0][0][n]; }
        if (fr == 15) {
#pragma unroll
            for (int ai = 0; ai < 2; ++ai)
#pragma unroll
                for (int n = 0; n < 2; ++n) *(PG8_LAS f32x4*)(EDGE + ((2 * ai + wr) * 2 + 1) * 128 + cg + 4 * n) = acc[ai][0][3][n]; }
        f32x4 w0[2], w1[2], w2[2], bb[2];
#pragma unroll
        for (int n = 0; n < 2; ++n) { w0[n] = *(const f32x4*)(cw + ff + 4 * n); w1[n] = *(const f32x4*)(cw + 5632 + ff + 4 * n); w2[n] = *(const f32x4*)(cw + 2 * 5632 + ff + 4 * n); bb[n] = *(const f32x4*)(cb + ff + 4 * n); }
        asm volatile("s_waitcnt lgkmcnt(0)" ::: "memory"); __builtin_amdgcn_s_barrier(); asm volatile("" ::: "memory");
        float* hb = HALO + (size_t)u.pm * 6 * 5632 + ff;
#pragma unroll
        for (int ai = 0; ai < 2; ++ai) {
            const int chunk = 2 * ai + wr;
            f32x4 ep[2], en[2];
#pragma unroll
            for (int n = 0; n < 2; ++n) {
                ep[n] = (chunk > 0) ? *(const PG8_LAS f32x4*)(EDGE + ((chunk - 1) * 2 + 1) * 128 + cg + 4 * n) : (f32x4){0.f, 0.f, 0.f, 0.f};
                en[n] = (chunk < 3) ? *(const PG8_LAS f32x4*)(EDGE + ((chunk + 1) * 2 + 0) * 128 + cg + 4 * n) : (f32x4){0.f, 0.f, 0.f, 0.f}; }
#pragma unroll
            for (int m = 0; m < 4; ++m) {
                const int row = u.pm * BM + ai * HALF + wr * 64 + m * 16 + fr;
                u32x4 w;
#pragma unroll
                for (int n = 0; n < 2; ++n) {
                    const f32x4 g = acc[ai][0][m][n], up = acc[ai][1][m][n]; f32x4 a;
#pragma unroll
                    for (int e = 0; e < 4; ++e) {
                        float gp = dppf<0x111>(g[e]);
                        if (m > 0) gp += dppf<0x10F>(acc[ai][0][m > 0 ? m - 1 : 0][n][e]);
                        else gp += (fr == 0) ? ep[n][e] : 0.f;
                        float gn = dppf<0x101>(g[e]);
                        if (m < 3) gn += dppf<0x11F>(acc[ai][0][m < 3 ? m + 1 : 3][n][e]);
                        else gn += (fr == 15) ? en[n][e] : 0.f;
                        const float z = w0[n][e] * gp + w1[n][e] * g[e] + w2[n][e] * gn + bb[n][e];
                        a[e] = silu_f(z) * up[e];
                    }
                    if (n == 0) { w.x = cvt_pk_bf16(a[0], a[1]); w.y = cvt_pk_bf16(a[2], a[3]); } else { w.z = cvt_pk_bf16(a[0], a[1]); w.w = cvt_pk_bf16(a[2], a[3]); }
                    if (chunk == 0 && m == 0 && fr < 2) { *(f32x4*)(hb + (size_t)fr * 5632 + 4 * n) = g; if (fr == 0) *(f32x4*)(hb + (size_t)4 * 5632 + 4 * n) = up; }
                    if (chunk == 3 && m == 3 && fr >= 14) { *(f32x4*)(hb + (size_t)(fr - 12) * 5632 + 4 * n) = g; if (fr == 15) *(f32x4*)(hb + (size_t)5 * 5632 + 4 * n) = up; }
                }
                *(u32x4*)(ACT + (size_t)row * 5632 + ff) = w;
            }
        }
    }
};
struct EpiF32 {
    static constexpr bool PERM = false;
    float* O; int ldc;
    __device__ __forceinline__ void operator()(const f32x4 (&acc)[2][2][4][2], const Unit& u, int wr, int wc, int fr, int fq, PG8_LAS unsigned char*) const {
        const int row0 = u.pm * BM + wr * 64 + fr, col0 = u.pn * BM + wc * 32 + 4 * fq;
#pragma unroll
        for (int ai = 0; ai < 2; ++ai)
#pragma unroll
            for (int m = 0; m < 4; ++m) { float* rowp = O + (size_t)(row0 + ai * HALF + m * 16) * ldc + col0;
#pragma unroll
                for (int bj = 0; bj < 2; ++bj)
#pragma unroll
                    for (int n = 0; n < 2; ++n) *(f32x4*)(rowp + bj * HALF + n * 16) = acc[ai][bj][m][n]; }
    }
};

template <class Epi, class Sched>
__device__ __forceinline__ void gemm_phase(PG8_LAS unsigned char* lds, PG8_LAS unsigned char* ldsx, const Gemm g, const Sched& S, const Epi& E) {
    int tid = threadIdx.x; asm volatile("" : "+v"(tid));
    const int wid = __builtin_amdgcn_readfirstlane(tid >> 6), lane = tid & 63, wr = wid >> 2, wc = wid & 3, fr = lane & 15, fq = lane >> 4;
    const int K = g.K;
    unsigned voffA[2], voffB[2];
#pragma unroll
    for (int i = 0; i < 2; ++i) { int R, C; stage_rc(tid * 16 + i * 8192, R, C); const int Rb = Epi::PERM ? ((R & ~31) + perm32(R & 31)) : R;
        voffA[i] = (unsigned)(R * K + C) * 2u; voffB[i] = (unsigned)(Rb * K + C) * 2u; }
    const size_t kstep = (size_t)(BK * 2);
    const size_t hstep = (size_t)HALF * K * 2;
    const size_t tstep = 2 * hstep;
    const unsigned ldsw = (unsigned)wid * 1024u;
    const int aoff = lds_byte(wr * 64 + fr, fq * 8), boff = lds_byte(wc * 32 + fr, fq * 8);
#define PG8_SA(b, h) (((b) * 2 + (h)) * HTB)
#define PG8_SB(b, h) ((4 + (b) * 2 + (h)) * HTB)
#define PG8_STAGE(bufoff, gbase, voff) do { _Pragma("unroll") for (int _i = 0; _i < 2; ++_i) \
        __builtin_amdgcn_global_load_lds((const unsigned*)((const char*)(gbase) + (voff)[_i]), (PG8_LAS unsigned*)(lds + (bufoff) + ldsw + _i * 8192), 16, 0, 0); } while (0)
#define PG8_LDA(dst, b, h) do { _Pragma("unroll") for (int m = 0; m < 4; ++m) _Pragma("unroll") for (int k = 0; k < 2; ++k) dst[m][k] = *(const PG8_LAS bf16x8*)(lds + PG8_SA(b, h) + aoff + m * 2048 + k * 1024); } while (0)
#define PG8_LDB(dst, b, h) do { _Pragma("unroll") for (int n = 0; n < 2; ++n) _Pragma("unroll") for (int k = 0; k < 2; ++k) dst[n][k] = *(const PG8_LAS bf16x8*)(lds + PG8_SB(b, h) + boff + n * 2048 + k * 1024); } while (0)
#define PG8_MMA(ai, bj, At, Bt) do { __builtin_amdgcn_s_setprio(1); _Pragma("unroll") for (int m = 0; m < 4; ++m) _Pragma("unroll") for (int n = 0; n < 2; ++n) _Pragma("unroll") for (int k = 0; k < 2; ++k) \
        acc[ai][bj][m][n] = __builtin_amdgcn_mfma_f32_16x16x32_bf16(Bt[n][k], At[m][k], acc[ai][bj][m][n], 0, 0, 0); __builtin_amdgcn_s_setprio(0); } while (0)
#define PG8_WAIT_V(n) asm volatile("s_waitcnt vmcnt(" #n ")" ::: "memory")
#define PG8_WAIT_L(n) asm volatile("s_waitcnt lgkmcnt(" #n ")" ::: "memory")
#define PG8_BAR __builtin_amdgcn_s_barrier()
#define PG8_SCHED __builtin_amdgcn_sched_barrier(0)
    Unit cur, nxt; int ui = 0;
    if (!S.next(0, cur)) return;
    f32x4 acc[2][2][4][2];
#pragma unroll
    for (int a = 0; a < 2; ++a)
#pragma unroll
        for (int b = 0; b < 2; ++b)
#pragma unroll
            for (int m = 0; m < 4; ++m)
#pragma unroll
                for (int n = 0; n < 2; ++n) acc[a][b][m][n] = (f32x4){0.f, 0.f, 0.f, 0.f};
    bf16x8 At[4][2], B0[2][2], B1[2][2];
    const char* cA = (const char*)g.A + (size_t)cur.pm * tstep + (size_t)cur.kt0 * kstep; const char* cB = (const char*)g.Bt + (size_t)cur.pn * tstep + (size_t)cur.kt0 * kstep;
    S.a_ready(cur);
    PG8_STAGE(PG8_SB(0, 0), cB, voffB); PG8_STAGE(PG8_SB(0, 1), cB + hstep, voffB); PG8_STAGE(PG8_SA(0, 0), cA, voffA); PG8_STAGE(PG8_SA(0, 1), cA + hstep, voffA);
    if (wr == 1) PG8_BAR;
    PG8_WAIT_V(2); PG8_BAR;
    PG8_STAGE(PG8_SB(1, 0), cB + kstep, voffB); PG8_STAGE(PG8_SA(1, 0), cA + kstep, voffA); PG8_STAGE(PG8_SB(1, 1), cB + hstep + kstep, voffB);
    PG8_WAIT_V(6); PG8_BAR;
    for (;;) {
        const bool has_next = S.next(ui + 1, nxt);
        const char* nA = has_next ? (const char*)g.A + (size_t)nxt.pm * tstep + (size_t)nxt.kt0 * kstep : cA; const char* nB = has_next ? (const char*)g.Bt + (size_t)nxt.pn * tstep + (size_t)nxt.kt0 * kstep : cB;
        const int nt = cur.nkt;
        for (int t = 0; t < nt; t += 2) {
            const bool last = (t == nt - 2);
            const char* a1 = cA + (size_t)(t + 1) * kstep;
            const char* a2 = last ? nA : cA + (size_t)(t + 2) * kstep; const char* b2 = last ? nB : cB + (size_t)(t + 2) * kstep;
            const char* a3 = a2 + kstep; const char* b3 = b2 + kstep;
            if (last && has_next) S.a_ready(nxt);
            PG8_LDB(B0, 0, 0); PG8_LDB(B1, 0, 1); PG8_SCHED; PG8_LDA(At, 0, 0); PG8_STAGE(PG8_SA(1, 1), a1 + hstep, voffA);
            PG8_WAIT_V(8); PG8_WAIT_L(0); PG8_BAR; PG8_MMA(0, 0, At, B0); PG8_MMA(0, 1, At, B1); PG8_BAR; PG8_SCHED;
            PG8_LDA(At, 0, 1); PG8_STAGE(PG8_SB(0, 0), b2, voffB); PG8_STAGE(PG8_SB(0, 1), b2 + hstep, voffB); PG8_STAGE(PG8_SA(0, 0), a2, voffA);
            PG8_WAIT_V(8); PG8_WAIT_L(0); PG8_BAR; PG8_MMA(1, 0, At, B0); PG8_MMA(1, 1, At, B1); PG8_BAR; PG8_SCHED;
            PG8_LDB(B0, 1, 0); PG8_LDB(B1, 1, 1); PG8_SCHED; PG8_LDA(At, 1, 0); PG8_STAGE(PG8_SA(0, 1), a2 + hstep, voffA);
            PG8_WAIT_V(8); PG8_WAIT_L(0); PG8_BAR; PG8_MMA(0, 0, At, B0); PG8_MMA(0, 1, At, B1); PG8_BAR; PG8_SCHED;
            PG8_LDA(At, 1, 1); PG8_STAGE(PG8_SB(1, 0), b3, voffB); PG8_STAGE(PG8_SB(1, 1), b3 + hstep, voffB); PG8_STAGE(PG8_SA(1, 0), a3, voffA);
            PG8_WAIT_V(8); PG8_WAIT_L(0); PG8_BAR; PG8_MMA(1, 0, At, B0); PG8_MMA(1, 1, At, B1); PG8_BAR; PG8_SCHED;
        }
        if (wr == 0) PG8_BAR;
        E(acc, cur, wr, wc, fr, fq, ldsx); S.done(cur);
        if (!has_next) break;
#pragma unroll
        for (int a = 0; a < 2; ++a)
#pragma unroll
            for (int b = 0; b < 2; ++b)
#pragma unroll
                for (int m = 0; m < 4; ++m)
#pragma unroll
                    for (int n = 0; n < 2; ++n) acc[a][b][m][n] = (f32x4){0.f, 0.f, 0.f, 0.f};
        cur = nxt; cA = nA; cB = nB; ++ui;
        if (wr == 1) PG8_BAR;
    }
    PG8_WAIT_V(0);
    PG8_BAR;
#undef PG8_SA
#undef PG8_SB
#undef PG8_STAGE
#undef PG8_LDA
#undef PG8_LDB
#undef PG8_MMA
#undef PG8_WAIT_V
#undef PG8_WAIT_L
#undef PG8_BAR
#undef PG8_SCHED
}
}

namespace att {
typedef unsigned short bf16;
using bf16x8 = __attribute__((ext_vector_type(8))) short;
using s16x4  = __attribute__((ext_vector_type(4))) short;
using f32x16 = __attribute__((ext_vector_type(16))) float;
using u32x4  = __attribute__((ext_vector_type(4))) unsigned;
constexpr int   D = 128, NW = 8, QBLK = 32, KVBLK = 64;
constexpr float SCALE = 0.088388347648318440f;
constexpr float THR = 8.f;
constexpr int SDEPTH = 1;
constexpr int LDQ = 1024, LDK = 256, LDO = 2048;
constexpr size_t SHM_V = KVBLK * D * 2, SHM_K = KVBLK * D * 2, SHM_ATTN = 3 * SHM_V + 3 * SHM_K + NW * 64 * 4;
#define KSWZ(row, colB) ((row) * 256 + ((colB) ^ (((row) & 7) << 4)))
#define SBAR() __builtin_amdgcn_sched_barrier(0)
__device__ __forceinline__ int crow(int r, int hi) { return (r & 3) + 8 * (r >> 2) + 4 * hi; }
typedef float f32x2a __attribute__((ext_vector_type(2))); typedef __bf16 bf16x2a __attribute__((ext_vector_type(2)));
__device__ __forceinline__ unsigned cvtpk(float lo, float hi) { f32x2a v = {lo, hi}; bf16x2a b = __builtin_convertvector(v, bf16x2a); return __builtin_bit_cast(unsigned, b); }
__device__ __forceinline__ void partialSM(f32x16& p0, f32x16& p1) {
  for (int r = 0; r < 16; ++r) p0[r] = __builtin_amdgcn_exp2f(p0[r]);
}
__device__ __forceinline__ void finishSM(f32x16& p0, f32x16& p1, float& l_reg, bf16x8& pa0, bf16x8& pa1, bf16x8& pa2, bf16x8& pa3) {
  for (int r = 0; r < 16; ++r) p1[r] = __builtin_amdgcn_exp2f(p1[r]);
  float ps = 0; for (int r = 0; r < 16; ++r) ps += p0[r]; for (int r = 0; r < 16; ++r) ps += p1[r];
  { auto rr = __builtin_amdgcn_permlane32_swap(__float_as_uint(ps), __float_as_uint(ps), false, false);
    ps = __uint_as_float(rr[0]) + __uint_as_float(rr[1]); }
  l_reg += ps;
#define PK4(P, BASE, OUT) do { unsigned a0 = cvtpk(P[BASE + 0], P[BASE + 1]), a1 = cvtpk(P[BASE + 2], P[BASE + 3]);   \
    unsigned b0 = cvtpk(P[BASE + 4], P[BASE + 5]), b1 = cvtpk(P[BASE + 6], P[BASE + 7]);                              \
    auto r0 = __builtin_amdgcn_permlane32_swap(a0, b0, false, false); auto r1 = __builtin_amdgcn_permlane32_swap(a1, b1, false, false); \
    u32x4 w = {r0[0], r1[0], r0[1], r1[1]}; OUT = *reinterpret_cast<bf16x8*>(&w); } while (0)
  PK4(p0, 0, pa0); PK4(p0, 8, pa1); PK4(p1, 0, pa2); PK4(p1, 8, pa3);
#undef PK4
}
__device__ __forceinline__ void qkt(f32x16& p0, f32x16& p1, const bf16* Ks, const bf16x8* qr, int r32, int hi) {
  p0 = f32x16{}; p1 = f32x16{};
  for (int d0 = 0; d0 < 8; ++d0) { int cb = (d0 * 16 + hi * 8) * 2;
    bf16x8 b0 = *reinterpret_cast<const bf16x8*>((const char*)Ks + KSWZ(r32, cb));
    bf16x8 b1 = *reinterpret_cast<const bf16x8*>((const char*)Ks + KSWZ(32 + r32, cb));
    p0 = __builtin_amdgcn_mfma_f32_32x32x16_bf16(b0, qr[d0], p0, 0, 0, 0);
    p1 = __builtin_amdgcn_mfma_f32_32x32x16_bf16(b1, qr[d0], p1, 0, 0, 0); }
}
__device__ __forceinline__ int v_st(int k, int c) { const int kk = (k & ~0xC) | ((k & 4) << 1) | ((k & 8) >> 1); return ((kk >> 3) * 4 + (c >> 5)) * 512 + ((kk & 7) * 32 + (c & 31)) * 2; }
__device__ __forceinline__ int v_rd_base(int lane) { return ((lane & 3) << 3) | (((lane >> 2) & 3) << 6) | (((lane >> 4) & 1) << 5) | (((lane >> 5) & 1) << 8); }
constexpr int v_rd_off(int d0, int ks, int half) { return d0 * 512 + ks * 4096 + half * 2048; }
typedef short v4i16_t __attribute__((ext_vector_type(4)));
template <int OFF> __device__ __forceinline__ s16x4 tr_read(int vb) {
  return __builtin_bit_cast(s16x4, __builtin_amdgcn_ds_read_tr16_b64_v4i16((__attribute__((address_space(3))) v4i16_t*)(unsigned long)(unsigned)(vb + OFF)));
}
template <int D0> __device__ __forceinline__ void pv_one(f32x16& od, int vb, bf16x8 pa0, bf16x8 pa1, bf16x8 pa2, bf16x8 pa3) {
  const s16x4 l0 = tr_read<v_rd_off(D0, 0, 0)>(vb), h0 = tr_read<v_rd_off(D0, 0, 1)>(vb), l1 = tr_read<v_rd_off(D0, 1, 0)>(vb), h1 = tr_read<v_rd_off(D0, 1, 1)>(vb);
  const s16x4 l2 = tr_read<v_rd_off(D0, 2, 0)>(vb), h2 = tr_read<v_rd_off(D0, 2, 1)>(vb), l3 = tr_read<v_rd_off(D0, 3, 0)>(vb), h3 = tr_read<v_rd_off(D0, 3, 1)>(vb);
#define PK(L, H) (bf16x8){L[0], L[1], L[2], L[3], H[0], H[1], H[2], H[3]}
  od = __builtin_amdgcn_mfma_f32_32x32x16_bf16(pa0, PK(l0, h0), od, 0, 0, 0);
  od = __builtin_amdgcn_mfma_f32_32x32x16_bf16(pa1, PK(l1, h1), od, 0, 0, 0);
  od = __builtin_amdgcn_mfma_f32_32x32x16_bf16(pa2, PK(l2, h2), od, 0, 0, 0);
  od = __builtin_amdgcn_mfma_f32_32x32x16_bf16(pa3, PK(l3, h3), od, 0, 0, 0);
#undef PK
}
__device__ __forceinline__ void pv_d0(f32x16* o, int vb, bf16x8 pa0, bf16x8 pa1, bf16x8 pa2, bf16x8 pa3) {
  pv_one<0>(o[0], vb, pa0, pa1, pa2, pa3); pv_one<1>(o[1], vb, pa0, pa1, pa2, pa3); pv_one<2>(o[2], vb, pa0, pa1, pa2, pa3); pv_one<3>(o[3], vb, pa0, pa1, pa2, pa3);
}
__device__ __forceinline__ void attn_dense_body(const bf16* __restrict__ Qb, const bf16* __restrict__ Kh, const bf16* __restrict__ Vh, bf16* __restrict__ Ob, int seq, char* lds) {
  int tid = threadIdx.x; asm volatile("" : "+v"(tid));
  const int wid = tid >> 6, lane = tid & 63, r32 = lane & 31, hi = lane >> 5;
  bf16* V_lds = (bf16*)lds; bf16* K_lds = (bf16*)(lds + 3 * SHM_V);
  float* ws = (float*)(lds + 3 * SHM_V + 3 * SHM_K) + wid * 64; float* li_l = ws;
  float l_reg = 0; f32x16 o[4] = {}; bf16x8 qr[8];
  const bf16* Qw = Qb + (long)(wid * QBLK + r32) * LDQ + hi * 8;
#pragma unroll
  for (int d0 = 0; d0 < 8; ++d0) qr[d0] = *reinterpret_cast<const bf16x8*>(Qw + d0 * 16);
  const int sr = tid >> 4, sc = (tid & 15) * 8, vst0 = v_st(sr, sc), vst1 = v_st(32 + sr, sc);
  const int vb0 = (int)(uintptr_t)V_lds + v_rd_base(lane);
  bf16x8 vs0, vs1, ks0, ks1;
#define SLOAD(k0) do { vs0 = *reinterpret_cast<const bf16x8*>(&Vh[(long)((k0) + sr) * LDK + sc]); vs1 = *reinterpret_cast<const bf16x8*>(&Vh[(long)((k0) + 32 + sr) * LDK + sc]); \
    ks0 = *reinterpret_cast<const bf16x8*>(&Kh[(long)((k0) + sr) * LDK + sc]); ks1 = *reinterpret_cast<const bf16x8*>(&Kh[(long)((k0) + 32 + sr) * LDK + sc]); } while (0)
#define SWRITE(slotB) do { *(bf16x8*)((char*)V_lds + (slotB) + vst0) = vs0; *(bf16x8*)((char*)V_lds + (slotB) + vst1) = vs1; const int kc = sc * 2;               \
    *(bf16x8*)((char*)K_lds + (slotB) + KSWZ(sr, kc)) = ks0; *(bf16x8*)((char*)K_lds + (slotB) + KSWZ(32 + sr, kc)) = ks1; } while (0)
  static_assert(SHM_V == SHM_K, "one slot offset serves both rings");
  f32x16 pA0, pA1, pB0, pB1; bf16x8 pa0, pa1, pa2, pa3; const int NT = seq / KVBLK;
  int s_prev = 0, s_cur = 0, s_next = (int)SHM_V;
#define ROT() do { s_prev = s_cur; s_cur = s_next; s_next = (s_next == 2 * (int)SHM_V) ? 0 : s_next + (int)SHM_V; } while (0)
#define STEP(PN0, PN1, PP0, PP1, jj) do { \
    SBAR(); qkt(PN0, PN1, (bf16*)((char*)K_lds + s_cur), qr, r32, hi); \
    finishSM(PP0, PP1, l_reg, pa0, pa1, pa2, pa3); SBAR(); \
    if ((jj) + 1 < NT) { SWRITE(s_next); } if ((jj) + 2 < NT) SLOAD(((jj) + 2) * KVBLK); SBAR(); \
    pv_d0(o, vb0 + s_prev, pa0, pa1, pa2, pa3); partialSM(PN0, PN1); \
    __syncthreads(); ROT(); } while (0)
  SLOAD(0); SWRITE(0); if (1 < NT) SLOAD(KVBLK); __syncthreads();
  qkt(pA0, pA1, K_lds, qr, r32, hi); partialSM(pA0, pA1);
  if (1 < NT) { SWRITE(s_next); } if (2 < NT) SLOAD(2 * KVBLK);
  __syncthreads(); ROT();
  int j = 1;
  for (; j + 1 < NT; j += 2) { STEP(pB0, pB1, pA0, pA1, j); STEP(pA0, pA1, pB0, pB1, j + 1); }
  SBAR(); qkt(pB0, pB1, (bf16*)((char*)K_lds + s_cur), qr, r32, hi);
  finishSM(pA0, pA1, l_reg, pa0, pa1, pa2, pa3); SBAR();
  pv_d0(o, vb0 + s_prev, pa0, pa1, pa2, pa3); partialSM(pB0, pB1);
  finishSM(pB0, pB1, l_reg, pa0, pa1, pa2, pa3); SBAR();
  pv_d0(o, vb0 + s_cur, pa0, pa1, pa2, pa3);
  if (hi == 0) li_l[r32] = l_reg; asm volatile("s_waitcnt lgkmcnt(0)" ::: "memory");
  float rli[16];
#pragma unroll
  for (int r = 0; r < 16; ++r) rli[r] = __builtin_amdgcn_rcpf(li_l[crow(r, hi)]);
  bf16* Ow = Ob + (long)(wid * QBLK) * LDO;
#pragma unroll
  for (int r = 0; r < 16; ++r) { int orow = crow(r, hi);
    for (int d0 = 0; d0 < 4; ++d0) { const float v = o[d0][r] * rli[r]; Ow[(long)orow * LDO + d0 * 32 + r32] = (bf16)(cvtpk(v, v) & 0xffffu); } }
  __syncthreads();
#undef SLOAD
#undef SWRITE
#undef ROT
#undef STEP
}
#undef KSWZ
#undef SBAR
}

constexpr int DM = 2048, SEQ = 8192, LCTX = 256, MROWS = SEQ + LCTX  , NLAYER = 4;
constexpr int INW = 6656, FF = 5632, FF2 = 2 * FF, HGW = 1024, PHW = 5120;
constexpr int NTILE = MROWS / 256;
constexpr float EPS = 1e-6f;

constexpr size_t MiB = 1u << 20;
constexpr size_t WS_CTL = 0, CTL_ZERO_BYTES = 1 * MiB;
constexpr size_t WS_MOD = 1 * MiB;
constexpr size_t WS_LB = WS_MOD + 512 * 1024;
constexpr size_t WS_AG = WS_LB + 64 * 1024;
constexpr size_t WS_WIN = 2 * MiB;
constexpr size_t WS_WOUT = WS_WIN + (size_t)NLAYER * INW * DM * 2;
constexpr size_t WS_WUP = WS_WOUT + (size_t)NLAYER * DM * DM * 2;
constexpr size_t WS_WDN = WS_WUP + (size_t)NLAYER * FF2 * DM * 2;
constexpr size_t WS_X = WS_WDN + (size_t)NLAYER * DM * FF * 2;
constexpr size_t WS_H = WS_X + (size_t)MROWS * DM * 4;
constexpr size_t WS_QA = WS_H + (size_t)MROWS * DM * 2;
constexpr size_t WS_KA = WS_QA + (size_t)MROWS * 1024 * 2;
constexpr size_t WS_VA = WS_KA + (size_t)MROWS * 256 * 2;
constexpr size_t WS_PH = WS_VA + (size_t)MROWS * 256 * 2;
constexpr size_t WS_MIX = WS_PH + (size_t)MROWS * PHW * 4;
constexpr size_t WS_OF = WS_MIX + (size_t)MROWS * DM * 2;
constexpr size_t WS_OB = WS_OF + (size_t)MROWS * HGW * 4;
constexpr size_t WS_U = WS_OB + (size_t)MROWS * HGW * 4;
constexpr size_t WS_SS = WS_U + (size_t)16 * 33 * 16384 * 4;
constexpr size_t WS_HALO = WS_SS + (size_t)16 * 33 * 16384 * 4;
constexpr size_t WS_ACT = WS_HALO + (size_t)NTILE * 6 * FF * 4;
constexpr int NSPLIT_O = 16, NSPLIT_D = 22;
constexpr size_t WS_PARTO = WS_ACT + (size_t)MROWS * FF * 2;
constexpr size_t WS_PARTD = WS_PARTO + (size_t)NSPLIT_O * 256 * DM * 4;
constexpr size_t WS_HB = WS_PARTD + (size_t)NSPLIT_D * 256 * DM * 4;
constexpr size_t WS_END = WS_HB + (size_t)MROWS * 3072 * 2;

constexpr int CW_BAR = 4096;

constexpr int RING_BYTES = 131072, LDSX_OFF = RING_BYTES, MISC_OFF = RING_BYTES + 12288, LDS_BYTES = 147456;

#define GAS __attribute__((address_space(1)))
#define LAS __attribute__((address_space(3)))
typedef unsigned short bf16;
typedef unsigned v4u __attribute__((ext_vector_type(4)));
typedef unsigned v2u __attribute__((ext_vector_type(2)));
typedef float f32x4 __attribute__((ext_vector_type(4)));
typedef short bf16x8 __attribute__((ext_vector_type(8)));
typedef short s16x4 __attribute__((ext_vector_type(4)));
#define LDS_WAIT() asm volatile("s_waitcnt lgkmcnt(0)" ::: "memory")
#define VM_WAIT() asm volatile("s_waitcnt vmcnt(0)" ::: "memory")
__device__ __forceinline__ unsigned f2bf(float f) { unsigned u = __builtin_bit_cast(unsigned, f); return (u + 0x7fffu + ((u >> 16) & 1u)) >> 16; }
typedef float f32x2_t __attribute__((ext_vector_type(2))); typedef __bf16 bf16x2_t __attribute__((ext_vector_type(2)));
__device__ __forceinline__ unsigned pk2(float lo, float hi) { f32x2_t v = {lo, hi}; bf16x2_t b = __builtin_convertvector(v, bf16x2_t); return __builtin_bit_cast(unsigned, b); }
__device__ __forceinline__ float silu(float x) { return x / (1.f + __expf(-x)); }

#define XB_TMO      128
#define XB_XCNT(j)  (256  + 64 * (j))
#define XB_XSUB(j)  (1280 + 64 * (j))
#define XB_XGEN(j)  (2304 + 64 * (j))
#define XB_TOP      3328
#define XB_TOPGEN   3392
#define XCD_BAR_WORDS 3456
#define XB_SPIN_CAP (1u << 18)
__device__ __forceinline__ unsigned xb_ld(unsigned* p)              { return __hip_atomic_load(p, __ATOMIC_RELAXED, __HIP_MEMORY_SCOPE_AGENT); }
__device__ __forceinline__ unsigned xb_add(unsigned* p, unsigned v) { return __hip_atomic_fetch_add(p, v, __ATOMIC_RELAXED, __HIP_MEMORY_SCOPE_AGENT); }
__device__ __forceinline__ unsigned xb_xcc_id() { return (unsigned)__builtin_amdgcn_s_getreg((3 << 11) | 20) & 0xFu; }
#define XB_SPIN(cond, bar) do { unsigned _sp = 0; while (cond) { __builtin_amdgcn_s_sleep(1); \
    if ((++_sp & 255u) == 0u) { if (xb_ld(&(bar)[XB_TMO])) break; if (_sp > XB_SPIN_CAP) { atomicAdd(&(bar)[XB_TMO], 1u); break; } } } } while (0)
struct XcdBarrier { unsigned* bar; unsigned x; volatile LAS unsigned* st; };
__device__ __forceinline__ XcdBarrier xcd_barrier_post(unsigned* bar, volatile LAS unsigned* st) {
    XcdBarrier b; b.bar = bar; b.x = xb_xcc_id(); b.st = st;
    if (threadIdx.x == 0) (void)xb_add(&bar[XB_XCNT(b.x)], 1u);
    return b;
}
__device__ __forceinline__ void xcd_barrier_complete(unsigned* bar, unsigned x, unsigned& nloc, unsigned& nx) {
    const unsigned G = gridDim.x * gridDim.y * gridDim.z;
    unsigned sum, cnt, mine, sp = 0u;
    for (;;) {
        sum = 0u; cnt = 0u; mine = 0u;
#pragma unroll
        for (unsigned j = 0; j < 16; ++j) { const unsigned c = xb_ld(&bar[XB_XCNT(j)]); sum += c; cnt += (c > 0u) ? 1u : 0u; mine = (j == x) ? c : mine; }
        if (sum == G) break;
        __builtin_amdgcn_s_sleep(1);
        if ((++sp & 255u) == 0u) { if (xb_ld(&bar[XB_TMO])) break; if (sp > XB_SPIN_CAP) { atomicAdd(&bar[XB_TMO], 1u); break; } }
    }
    nloc = mine > 0u ? mine : 1u; nx = cnt > 0u ? cnt : 1u;
}
__device__ __forceinline__ void xcd_barrier(const XcdBarrier& b) {
    asm volatile("s_waitcnt vmcnt(0)" ::: "memory");
    __syncthreads();
    if (threadIdx.x == 0) {
        unsigned* bar = b.bar;
        __builtin_amdgcn_s_waitcnt(0);
        unsigned nloc = b.st[0], nx = b.st[1];
        if (nloc == 0u) { xcd_barrier_complete(bar, b.x, nloc, nx); b.st[0] = nloc; b.st[1] = nx; }
        const unsigned old = xb_add(&bar[XB_XSUB(b.x)], 1u);
        const unsigned gen = old / nloc;
        if (old + 1u == (gen + 1u) * nloc) {
            __builtin_amdgcn_fence(__ATOMIC_RELEASE, "agent");
            asm volatile("s_waitcnt vmcnt(0)" ::: "memory");
            const unsigned og = xb_add(&bar[XB_TOP], 1u);
            const unsigned tg = og / nx;
            if (og + 1u == (tg + 1u) * nx) xb_add(&bar[XB_TOPGEN], 1u);
            else XB_SPIN(xb_ld(&bar[XB_TOPGEN]) == tg, bar);
            __builtin_amdgcn_fence(__ATOMIC_ACQUIRE, "agent");
            xb_add(&bar[XB_XGEN(b.x)], 1u);
            asm volatile("s_waitcnt vmcnt(0)" ::: "memory");
        } else {
            XB_SPIN(xb_ld(&bar[XB_XGEN(b.x)]) == gen, bar);
            __builtin_amdgcn_fence(__ATOMIC_ACQUIRE, "agent");
            asm volatile("s_waitcnt vmcnt(0)" ::: "memory");
        }
    }
    __syncthreads();
}

__device__ __attribute__((noinline)) void xcd_barrier_call(unsigned* barp, unsigned x, volatile LAS unsigned* st) { XcdBarrier b; b.bar = barp; b.x = x; b.st = st; xcd_barrier(b); }

__device__ __forceinline__ float wave_sum(float v) {
#pragma unroll
    for (int o = 1; o < 64; o <<= 1) v += __shfl_xor(v, o);
    return v;
}
__device__ __forceinline__ int rowmap(int mode, int n) {
    if (mode == 1) { if (n >= 1280) return n; const int hb = n & ~127, d = n & 127, f = d & 31;
        return hb + 64 * (d >> 6) + 32 * (f >> 4) + 8 * ((f >> 2) & 3) + 4 * ((d >> 5) & 1) + (d & 3); }
    if (mode == 2) { if (n < FF) return (n >> 7) * 256 + (n & 127); const int c = n - FF; return (c >> 7) * 256 + 128 + (c & 127); }
    return n;
}
__device__ __forceinline__ void transpose_item(const float* W, int K, int N, bf16* WT, int mode, LAS float* scr, int item, int lane) {
    const int nblk = N / 32, kb = item / nblk, nb = item % nblk, k0 = 64 * kb, n0 = 32 * nb;
    { const int kr = lane >> 3, c4 = (lane & 7) * 4; f32x4 v[8];
#pragma unroll
    for (int i = 0; i < 8; ++i) v[i] = *(const f32x4*)(W + (size_t)(k0 + kr + 8 * i) * N + n0 + c4);
#pragma unroll
    for (int i = 0; i < 8; ++i) { LAS float* d = scr + (kr + 8 * i) * 33 + c4; d[0] = v[i][0]; d[1] = v[i][1]; d[2] = v[i][2]; d[3] = v[i][3]; } }
    LDS_WAIT(); asm volatile("" ::: "memory");
    const int c = lane & 7;
#pragma unroll
    for (int j = 0; j < 4; ++j) { const int n = (lane >> 3) + 8 * j; const LAS float* s = scr + (8 * c) * 33 + n;
        v4u o; o.x = pk2(s[0 * 33], s[1 * 33]); o.y = pk2(s[2 * 33], s[3 * 33]); o.z = pk2(s[4 * 33], s[5 * 33]); o.w = pk2(s[6 * 33], s[7 * 33]);
        *(v4u*)(WT + (size_t)rowmap(mode, n0 + n) * K + k0 + 8 * c) = o; }
    LDS_WAIT(); asm volatile("" ::: "memory");
}
__device__ __forceinline__ void norm_mod_row(const float* xin, float* xrow, const float* w, const float* sh, const float* sc, bf16* orow, int lane, const float* prow, int nsplit, const float* gate) {
    const f32x4* xr = (const f32x4*)xin + lane; f32x4 v[8]; float s = 0.f;
#pragma unroll
    for (int j = 0; j < 8; ++j) v[j] = xr[64 * j];
    if (prow) {
        f32x4 a[8];
#pragma unroll
        for (int j = 0; j < 8; ++j) a[j] = (f32x4){0.f, 0.f, 0.f, 0.f};
        for (int sp = 0; sp < nsplit; ++sp) {
#pragma unroll
            for (int j = 0; j < 8; ++j) a[j] += ((const f32x4*)(prow + (size_t)sp * 256 * DM))[lane + 64 * j]; }
#pragma unroll
        for (int j = 0; j < 8; ++j) { v[j] += a[j] * ((const f32x4*)gate)[lane + 64 * j]; ((f32x4*)xrow)[lane + 64 * j] = v[j]; }
    }
#pragma unroll
    for (int j = 0; j < 8; ++j) s += (v[j][0] * v[j][0] + v[j][1] * v[j][1]) + (v[j][2] * v[j][2] + v[j][3] * v[j][3]);
    const float rstd = rsqrtf(wave_sum(s) * (1.f / DM) + EPS);
    v2u* o8 = (v2u*)orow + lane;
#pragma unroll
    for (int j = 0; j < 8; ++j) { const f32x4 wv = ((const f32x4*)w)[lane + 64 * j], shv = ((const f32x4*)sh)[lane + 64 * j], scv = ((const f32x4*)sc)[lane + 64 * j];
        const f32x4 y = v[j] * rstd * wv * (scv + 1.f) + shv; v2u o; o.x = pk2(y[0], y[1]); o.y = pk2(y[2], y[3]); o8[64 * j] = o; }
}

__device__ __forceinline__ void norm_mod_row_wg(const float* xin, float* xrow, const float* w, const float* sh, const float* sc, bf16* orow, int lane, int wave, LAS float* red, const float* prow, int nsplit, const float* gate) {
    const int i4 = lane + 64 * wave;
    f32x4 v = ((const f32x4*)xin)[i4];
    if (prow) { f32x4 a = {0.f, 0.f, 0.f, 0.f};
#pragma unroll 8
        for (int sp = 0; sp < nsplit; ++sp) a += ((const f32x4*)(prow + (size_t)sp * 256 * DM))[i4];
        v += a * ((const f32x4*)gate)[i4]; ((f32x4*)xrow)[i4] = v; }
    const float s = wave_sum((v[0] * v[0] + v[1] * v[1]) + (v[2] * v[2] + v[3] * v[3]));
    __syncthreads();
    if (lane == 0) red[wave] = s;
    __syncthreads();
    float tot = 0.f;
#pragma unroll
    for (int q = 0; q < 8; ++q) tot += red[q];
    const float rstd = rsqrtf(tot * (1.f / DM) + EPS);
    const f32x4 wv = ((const f32x4*)w)[i4], shv = ((const f32x4*)sh)[i4], scv = ((const f32x4*)sc)[i4];
    const f32x4 y = v * rstd * wv * (scv + 1.f) + shv; v2u o; o.x = pk2(y[0], y[1]); o.y = pk2(y[2], y[3]); ((v2u*)orow)[i4] = o;
}

__device__ __forceinline__ float dpp_add(float v, float src_shifted) { return v + src_shifted; }
#define ROW_SHR_ADD(v, n) ((v) + __builtin_bit_cast(float, __builtin_amdgcn_update_dpp(0, __builtin_bit_cast(int, (v)), 0x110 + (n), 0xf, 0xf, false)))

constexpr int HG_QT = 0, HG_KT = 17408, HG_KH = 34816, HG_VT = 53248, HG_ET = 71680, HG_PQ = 272, HG_PS = 144;
constexpr int HG_SSQ = 73728;
template <int MODE>
__device__ __forceinline__ void hg_unit(LAS unsigned char* lds, const float* __restrict__ PH, const float* __restrict__ LBl  ,
                                        float* __restrict__ Ubuf, float* __restrict__ AG, const float* __restrict__ SS, float* __restrict__ OX, int h, int dir, int T,
                                        const bf16* __restrict__ HBp, const float* __restrict__ OFr = nullptr, bf16* __restrict__ MIXo = nullptr, const float* __restrict__ hgw = nullptr) {
    constexpr bool OUT = MODE != 0, SUM = (MODE == 0 || MODE == 2), FUSE = MODE == 3;
    int tid = threadIdx.x; asm volatile("" : "+v"(tid));
    const int lane = tid & 63, w = __builtin_amdgcn_readfirstlane(tid >> 6), l15 = lane & 15, g = lane >> 4;
    const int hd = dir * 8 + h, grp = (dir == 0 || T == 0) ? T : (NTILE - T), col0 = 16 * w;
    f32x4 lbv[4];
#pragma unroll
    for (int k = 0; k < 4; ++k) lbv[k] = *(const f32x4*)(LBl + h * 128 + col0 + 4 * k);
    f32x4 S[8];
    if (MODE == 1 || MODE == 3) { const float* sp = SS + (size_t)(hd * NTILE + grp) * 16384 + col0 + l15;
#pragma unroll
        for (int t8 = 0; t8 < 8; ++t8)
#pragma unroll
            for (int r = 0; r < 4; ++r) S[t8][r] = sp[(16 * t8 + 4 * g + r) * 128]; }
    else {
#pragma unroll
        for (int t8 = 0; t8 < 8; ++t8) S[t8] = (f32x4){0.f, 0.f, 0.f, 0.f}; }
    float aprod = 1.f;
    LAS unsigned char* VTw = lds + HG_VT + w * 2304;
    LAS float* ET = (LAS float*)(lds + HG_ET);
    f32x4 xv[4]; v4u qraw[2], vraw[2];
    const int rstep = (dir == 0) ? 64 : -64;
    const float* pr = PH + (size_t)((dir == 0) ? (T * 256 + lane) : (T * 256 + 255 - lane)) * PHW + h * 128 + col0;
    const bf16* pb = HBp + (size_t)((dir == 0) ? (T * 256 + lane) : (T * 256 + 255 - lane)) * 3072 + h * 128 + col0;
#define HG_LOAD() do { _Pragma("unroll") for (int k = 0; k < 4; ++k) xv[k] = *(const f32x4*)(pr + 1024 * (1 + dir) + 4 * k); \
    _Pragma("unroll") for (int k = 0; k < 2; ++k) { if (OUT) qraw[k] = *(const v4u*)(pb + 8 * k); vraw[k] = *(const v4u*)(pb + 1024 + 8 * k); } } while (0)
    HG_LOAD();
    f32x4 otot[4], ofv[4], gtv[4]; float hwv = 0.f;
    if (FUSE) hwv = hgw[col0 + l15];
    LAS float* SSQ = (LAS float*)(lds + HG_SSQ);
#define HG_FINISH(cc) do { _Pragma("unroll") for (int j = 0; j < 4; ++j) { f32x4 ss4 = {0.f, 0.f, 0.f, 0.f}; \
        _Pragma("unroll") for (int w2 = 0; w2 < 8; ++w2) ss4 += *(const LAS f32x4*)(SSQ + w2 * 64 + 16 * j + 4 * g); \
        _Pragma("unroll") for (int rr = 0; rr < 4; ++rr) { const float rstd = rsqrtf(ss4[rr] * (1.f / 128.f) + EPS); const float y = otot[j][rr] * rstd * hwv * silu(gtv[j][rr]); \
            const int orow = T * 256 + 255 - ((cc) * 64 + 16 * j + 4 * g + rr); MIXo[(size_t)orow * DM + 1024 + h * 128 + col0 + l15] = (bf16)(pk2(y, y) & 0xffffu); } } } while (0)
    for (int c = 0; c < 4; ++c) {
        if (c > 0) __syncthreads();
        if (FUSE && c > 0) HG_FINISH(c - 1);
        unsigned qt[8], kt[8];
        f32x4 etv[4];
#pragma unroll
        for (int k = 0; k < 4; ++k) {
            float qe[4], ke[4];
#pragma unroll
            for (int e = 0; e < 4; ++e) {
                const float x = xv[k][e], lb = lbv[k][e];
                const float sg = __builtin_amdgcn_rcpf(1.f + __expf(-x));
                const float fg = lb + (1.f - lb) * sg;
                const float kk = 1.f - fg;
                float gl = fmaxf(__logf(fg), -80.f);
                float lc = gl; lc = ROW_SHR_ADD(lc, 1); lc = ROW_SHR_ADD(lc, 2); lc = ROW_SHR_ADD(lc, 4); lc = ROW_SHR_ADD(lc, 8);
                const float elc = __expf(lc);
                const float tot = __shfl(lc, lane | 15);
                etv[k][e] = elc;
                const float kh = kk * __expf(tot - lc);
                const unsigned vword = vraw[k >> 1][2 * (k & 1) + (e >> 1)];
                *(LAS bf16*)(lds + HG_KH + (col0 + 4 * k + e) * HG_PS + lane * 2) = (bf16)(pk2(kh, kh) & 0xffffu);
                *(LAS bf16*)(VTw + (4 * k + e) * HG_PS + lane * 2) = (bf16)((e & 1) ? (vword >> 16) : (vword & 0xffffu));
                if (OUT) { const unsigned qword = qraw[k >> 1][2 * (k & 1) + (e >> 1)]; const float qf = __uint_as_float((e & 1) ? (qword & 0xffff0000u) : (qword << 16));
                    qe[e] = qf * elc; ke[e] = kk * __builtin_amdgcn_rcpf(fmaxf(elc, 8.7565e-27f)); }
            }
            if (OUT) { qt[2 * k] = pk2(qe[0], qe[1]); qt[2 * k + 1] = pk2(qe[2], qe[3]); kt[2 * k] = pk2(ke[0], ke[1]); kt[2 * k + 1] = pk2(ke[2], ke[3]); }
        }
        if (OUT) {
            *(LAS v4u*)(lds + HG_QT + lane * HG_PQ + col0 * 2) = (v4u){qt[0], qt[1], qt[2], qt[3]}; *(LAS v4u*)(lds + HG_QT + lane * HG_PQ + col0 * 2 + 16) = (v4u){qt[4], qt[5], qt[6], qt[7]};
            *(LAS v4u*)(lds + HG_KT + lane * HG_PQ + col0 * 2) = (v4u){kt[0], kt[1], kt[2], kt[3]}; *(LAS v4u*)(lds + HG_KT + lane * HG_PQ + col0 * 2 + 16) = (v4u){kt[4], kt[5], kt[6], kt[7]};
        }
        if (l15 == 15) {
#pragma unroll
            for (int k = 0; k < 4; ++k) *(LAS f32x4*)(ET + g * 128 + col0 + 4 * k) = etv[k]; }
        if (c < 3) { pr += (ptrdiff_t)rstep * PHW; pb += (ptrdiff_t)rstep * 3072; HG_LOAD(); }
        __syncthreads();
        if (FUSE) {
#pragma unroll
            for (int j = 0; j < 4; ++j)
#pragma unroll
                for (int rr = 0; rr < 4; ++rr) { const size_t orow = (size_t)(T * 256 + 255 - (c * 64 + 16 * j + 4 * g + rr));
                    ofv[j][rr] = OFr[orow * HGW + h * 128 + col0 + l15]; gtv[j][rr] = __uint_as_float((unsigned)HBp[orow * 3072 + 2048 + h * 128 + col0 + l15] << 16); } }
        if (SUM && tid < 128) aprod *= (ET[tid] * ET[128 + tid]) * (ET[256 + tid] * ET[384 + tid]);
#pragma unroll
        for (int j = 0; j < 4; ++j) {
            const v2u vfr = *(const LAS v2u*)(VTw + l15 * HG_PS + (16 * j + 4 * g) * 2);
            const s16x4 vf = __builtin_bit_cast(s16x4, vfr);
            if (OUT) {
                f32x4 o = {0.f, 0.f, 0.f, 0.f}, st = {0.f, 0.f, 0.f, 0.f};
#pragma unroll
                for (int kk = 0; kk < 4; ++kk) {
                    const LAS unsigned char* qp = lds + HG_QT + (16 * j + l15) * HG_PQ + (32 * kk + 4 * g) * 2;
                    const LAS unsigned char* kp = lds + HG_KT + (16 * j + l15) * HG_PQ + (32 * kk + 4 * g) * 2;
                    const v2u q0 = *(const LAS v2u*)qp, q1 = *(const LAS v2u*)(qp + 32), k0 = *(const LAS v2u*)kp, k1 = *(const LAS v2u*)(kp + 32);
                    const bf16x8 qf = __builtin_bit_cast(bf16x8, (v4u){q0.x, q0.y, q1.x, q1.y}), kf = __builtin_bit_cast(bf16x8, (v4u){k0.x, k0.y, k1.x, k1.y});
                    const bf16x8 sf = __builtin_bit_cast(bf16x8, (v4u){pk2(S[2 * kk][0], S[2 * kk][1]), pk2(S[2 * kk][2], S[2 * kk][3]), pk2(S[2 * kk + 1][0], S[2 * kk + 1][1]), pk2(S[2 * kk + 1][2], S[2 * kk + 1][3])});
                    o = __builtin_amdgcn_mfma_f32_16x16x32_bf16(qf, sf, o, 0, 0, 0);
                    st = __builtin_amdgcn_mfma_f32_16x16x32_bf16(kf, qf, st, 0, 0, 0);
                }
#pragma unroll
                for (int rr = 0; rr < 4; ++rr) if (4 * g + rr > l15) st[rr] = 0.f;
                const s16x4 pf = __builtin_bit_cast(s16x4, (v2u){pk2(st[0], st[1]), pk2(st[2], st[3])});
                const f32x4 oi = __builtin_amdgcn_mfma_f32_16x16x16bf16_1k(pf, vf, (f32x4){0.f, 0.f, 0.f, 0.f}, 0, 0, 0);
                o += oi;
                if (FUSE) otot[j] = o + ofv[j];
                else {
#pragma unroll
                for (int rr = 0; rr < 4; ++rr) { const int tt = c * 64 + 16 * j + 4 * g + rr; const int orow = (dir == 0) ? (T * 256 + tt) : (T * 256 + 255 - tt);
                    OX[(size_t)orow * HGW + h * 128 + col0 + l15] = o[rr]; } }
            }
#pragma unroll
            for (int t8 = 0; t8 < 8; ++t8) {
                const f32x4 ev = *(const LAS f32x4*)(ET + j * 128 + 16 * t8 + 4 * g);
                const v2u kh = *(const LAS v2u*)(lds + HG_KH + (16 * t8 + l15) * HG_PS + (16 * j + 4 * g) * 2);
                S[t8] = __builtin_amdgcn_mfma_f32_16x16x16bf16_1k(__builtin_bit_cast(s16x4, kh), vf, S[t8] * ev, 0, 0, 0);
            }
        }
        if (FUSE) {
#pragma unroll
            for (int j = 0; j < 4; ++j) { f32x4 q4 = otot[j] * otot[j];
#pragma unroll
                for (int rr = 0; rr < 4; ++rr) { float v = q4[rr]; v = ROW_SHR_ADD(v, 1); v = ROW_SHR_ADD(v, 2); v = ROW_SHR_ADD(v, 4); v = ROW_SHR_ADD(v, 8); q4[rr] = v; }
                if (l15 == 15) *(LAS f32x4*)(SSQ + w * 64 + 16 * j + 4 * g) = q4; } }
    }
#undef HG_LOAD
    if (SUM) {
        float* up = Ubuf + (size_t)(hd * NTILE + grp) * 16384 + col0 + l15;
#pragma unroll
        for (int t8 = 0; t8 < 8; ++t8)
#pragma unroll
            for (int r = 0; r < 4; ++r) up[(16 * t8 + 4 * g + r) * 128] = S[t8][r];
        if (tid < 128) AG[(hd * NTILE + grp) * 128 + tid] = aprod;
    }
    VM_WAIT();
    __syncthreads();
    if (FUSE) { HG_FINISH(3); __syncthreads(); }
#undef HG_FINISH
}

constexpr int NWAVES = 8;
enum { PH_PRO = 0, PH_NORM1 = 1, PH_INPROJ = 2, PH_ATTN = 3, PH_HG1 = 4, PH_HG2 = 5, PH_HG3 = 6, PH_HGOUT = 7, PH_OUTPROJ = 8, PH_NORM2 = 9, PH_UP = 10, PH_CONV = 11, PH_DOWN = 12, PH_FINAL = 13, PH_COUNT = 14 };
struct Args { const float* in[19]; float* out; unsigned char* ws; int ph_lo, ph_hi, l_lo, l_hi, use_bar, pad; };

__global__ void __launch_bounds__(NWAVES * 64, 2) fwd_kernel(Args args) {
    extern __shared__ __attribute__((aligned(16))) unsigned char lds_raw[];
    LAS unsigned char* lds = (LAS unsigned char*)lds_raw;
    volatile LAS unsigned* MISC = (volatile LAS unsigned*)(lds + MISC_OFF);
    const int G = gridDim.x; const int bx = blockIdx.x; const int vcu = (G % 8 == 0) ? (bx % 8) * (G / 8) + bx / 8 : bx;
    if (threadIdx.x < 64) MISC[threadIdx.x] = 0u;
    __syncthreads();
    XcdBarrier bar; bar.bar = (unsigned*)(args.ws + WS_CTL) + CW_BAR; bar.x = 0; bar.st = nullptr;
#if MK_ONE_LAUNCH
    bar = xcd_barrier_post((unsigned*)(args.ws + WS_CTL) + CW_BAR, MISC + 8);
#define GRID_BAR() xcd_barrier_call(bar.bar, bar.x, bar.st)
#define IN(k) true
#else
    const bool use_bar = args.use_bar != 0;
    if (use_bar) bar = xcd_barrier_post((unsigned*)(args.ws + WS_CTL) + CW_BAR, MISC + 8);
#define GRID_BAR() do { if (use_bar) xcd_barrier(bar); } while (0)
    const int lo = args.ph_lo, hi = args.ph_hi;
#define IN(k) (lo <= (k) && (k) < hi)
#endif
#define PHASE_BEGIN() size_t wsz_ = 0; asm volatile("" : "+s"(wsz_)); unsigned char* ws = args.ws + wsz_; int tid = threadIdx.x; asm volatile("" : "+v"(tid)); \
    const int lane = tid & 63, wave = __builtin_amdgcn_readfirstlane(tid >> 6); const int gw = vcu * NWAVES + wave, NGW = G * NWAVES; const int gt = vcu * (NWAVES * 64) + tid, NGT = G * NWAVES * 64; \
    (void)lane; (void)wave; (void)gw; (void)NGW; (void)gt; (void)NGT
#define WSP(T, off) ((T*)(ws + (off)))

    if (IN(PH_PRO)) {
        PHASE_BEGIN();
        const float* w_in = args.in[8]; const float* w_out = args.in[13]; const float* w_up = args.in[14]; const float* w_down = args.in[17];
        bf16* WIN = WSP(bf16, WS_WIN); bf16* WOUT = WSP(bf16, WS_WOUT); bf16* WUP = WSP(bf16, WS_WUP); bf16* WDN = WSP(bf16, WS_WDN);
        LAS float* scr = (LAS float*)(lds + wave * 16384);
        constexpr int I_IN = (DM / 64) * (INW / 32), I_OUT = (DM / 64) * (DM / 32), I_UP = (DM / 64) * (FF2 / 32), I_DN = (FF / 64) * (DM / 32), I_L = I_IN + I_OUT + I_UP + I_DN;
        for (int it = gw; it < NLAYER * I_L; it += NGW) {
            const int l = it / I_L; int r = it % I_L;
            if (r < I_IN) { transpose_item(w_in + (size_t)l * DM * INW, DM, INW, WIN + (size_t)l * INW * DM, 1, scr, r, lane); continue; } r -= I_IN;
            if (r < I_OUT) { transpose_item(w_out + (size_t)l * DM * DM, DM, DM, WOUT + (size_t)l * DM * DM, 0, scr, r, lane); continue; } r -= I_OUT;
            if (r < I_UP) { transpose_item(w_up + (size_t)l * DM * FF2, DM, FF2, WUP + (size_t)l * FF2 * DM, 2, scr, r, lane); continue; } r -= I_UP;
            transpose_item(w_down + (size_t)l * FF * DM, FF, DM, WDN + (size_t)l * DM * FF, 0, scr, r, lane);
        }
        { const float* hg_lb_logits = args.in[11]; float* LB = WSP(float, WS_LB);
        for (int i = gt; i < 2 * 1024; i += NGT) { const int d = i / 1024, k = i % 1024; float lg[4], mx = -1e30f;
#pragma unroll
            for (int l = 0; l < 4; ++l) { lg[l] = hg_lb_logits[(d * 4 + l) * 1024 + k]; mx = fmaxf(mx, lg[l]); }
            float den = 0.f;
#pragma unroll
            for (int l = 0; l < 4; ++l) { lg[l] = __expf(lg[l] - mx); den += lg[l]; }
            float cum = 0.f;
#pragma unroll
            for (int l = 0; l < 4; ++l) { const float sm = lg[l] / den; if (l > 0) cum += sm; LB[(d * 4 + l) * 1024 + k] = cum; } } }
        __syncthreads();
        { const float* in_c = args.in[1]; const float* in_cctx = args.in[3]; const float* w_mod = args.in[4]; const float* b_mod = args.in[5]; float* MOD = WSP(float, WS_MOD);
        LAS float* sv = (LAS float*)(lds + 0);
        LAS float* red = (LAS float*)(lds + 16384);
        for (int i = tid; i < 2 * DM; i += NWAVES * 64) { const float cv = (i < DM) ? in_c[i] : in_cctx[i - DM]; sv[i] = silu(cv); }
        __syncthreads();
        for (int it = vcu; it < NLAYER * 64; it += G) {
            const int l = it >> 6, c0 = (it & 63) * 192; const int kq = tid / 48, cq = tid % 48;
            f32x4 a0 = {0.f, 0.f, 0.f, 0.f}, a1 = {0.f, 0.f, 0.f, 0.f};
            if (tid < 480) { const float* wp = w_mod + (size_t)l * DM * 12288 + c0 + 4 * cq;
#pragma unroll 8
                for (int k = kq; k < DM; k += 10) { const f32x4 wv = *(const f32x4*)(wp + (size_t)k * 12288); a0 += wv * sv[k]; a1 += wv * sv[DM + k]; }
                *(LAS f32x4*)(red + (kq * 48 + cq) * 8) = a0; *(LAS f32x4*)(red + (kq * 48 + cq) * 8 + 4) = a1; }
            __syncthreads();
            if (tid < 384) { const int cq2 = tid >> 3, j = tid & 7; float sacc = 0.f;
#pragma unroll
                for (int q = 0; q < 10; ++q) sacc += red[(q * 48 + cq2) * 8 + j];
                const int which = j >> 2, col = c0 + 4 * cq2 + (j & 3);
                MOD[(l * 2 + which) * 12288 + col] = sacc + b_mod[l * 12288 + col]; }
            __syncthreads();
        } }
        GRID_BAR();
    }

#if MK_ONE_LAUNCH
    for (int l = 0; l < NLAYER; ++l) {
#else
    for (int l = args.l_lo; l < args.l_hi; ++l) {
#endif
        if (IN(PH_NORM1)) {
            PHASE_BEGIN();
            const float* modl = WSP(float, WS_MOD) + (size_t)(l * 2 + 0) * 12288; const float* modc = modl + 12288; float* X = WSP(float, WS_X); bf16* H = WSP(bf16, WS_H); const float* nw = args.in[6] + l * DM;
            const float* partd = WSP(float, WS_PARTD);
            for (int m = vcu; m < LCTX; m += G)
                norm_mod_row_wg(l > 0 ? X + (size_t)m * DM : args.in[2] + (size_t)m * DM, X + (size_t)m * DM, nw, modc, modc + DM, H + (size_t)m * DM, lane, wave, (LAS float*)lds, l > 0 ? partd + (size_t)m * DM : nullptr, NSPLIT_D, modc - 2 * 12288 + 5 * DM);
            for (int m = LCTX + gw; m < MROWS; m += NGW)
                norm_mod_row(l > 0 ? X + (size_t)m * DM : args.in[0] + (size_t)(m - LCTX) * DM, X + (size_t)m * DM, nw, modl, modl + DM, H + (size_t)m * DM, lane, nullptr, 0, nullptr);
            GRID_BAR();
        }
        if (IN(PH_INPROJ)) {
            PHASE_BEGIN();
            pg8::Gemm g{WSP(bf16, WS_H), WSP(bf16, WS_WIN) + (size_t)l * INW * DM, MROWS, INW, DM}; pg8::StaticOrder S; S.init(MROWS, INW, DM, G, bx);
            pg8::EpiInProj E{WSP(bf16, WS_QA), WSP(bf16, WS_KA), WSP(bf16, WS_VA), WSP(float, WS_PH), args.in[9] + l * 128, args.in[10] + l * 128, WSP(bf16, WS_HB)};
            pg8::gemm_phase<pg8::EpiInProj, pg8::StaticOrder>(lds, lds + LDSX_OFF, g, S, E);
            GRID_BAR();
        }
        if (IN(PH_ATTN)) {
            PHASE_BEGIN();
            const bf16* QA = WSP(bf16, WS_QA); const bf16* KA = WSP(bf16, WS_KA); const bf16* VA = WSP(bf16, WS_VA); bf16* MIX = WSP(bf16, WS_MIX);
            for (int u = vcu; u < 256; u += G) { const long h = u >> 5, qb = u & 31;
                att::attn_dense_body(QA + ((LCTX + qb * 256) * 1024 + h * 128), KA + (h >> 2) * 128, VA + (h >> 2) * 128, MIX + ((LCTX + qb * 256) * 2048 + h * 128), MROWS, (char*)lds_raw);
                if (qb == 0) att::attn_dense_body(QA + h * 128, KA + (h >> 2) * 128, VA + (h >> 2) * 128, MIX + h * 128, LCTX, (char*)lds_raw);
            }
        }
        if (IN(PH_HG1)) {
            PHASE_BEGIN();
            for (int u = vcu; u < 16 * 32; u += G) { const int hd = u >> 5, grp = (hd < 8) ? (u & 31) : ((u + 16) & 31);
                const int dir = hd >> 3, h = hd & 7; const int T = (dir == 0 || grp == 0) ? grp : (NTILE - grp);
                if (grp == 0) hg_unit<2>(lds, WSP(float, WS_PH), WSP(float, WS_LB) + (dir * 4 + l) * 1024, WSP(float, WS_U), WSP(float, WS_AG), nullptr, dir == 0 ? WSP(float, WS_OF) : WSP(float, WS_OB), h, dir, 0, WSP(bf16, WS_HB));
                else hg_unit<0>(lds, WSP(float, WS_PH), WSP(float, WS_LB) + (dir * 4 + l) * 1024, WSP(float, WS_U), WSP(float, WS_AG), nullptr, nullptr, h, dir, T, WSP(bf16, WS_HB)); }
            GRID_BAR();
        }
        if (IN(PH_HG2)) {
            PHASE_BEGIN();
            const float* UB = WSP(float, WS_U); const float* AG = WSP(float, WS_AG); float* SS = WSP(float, WS_SS);
            for (int e = gt; e < 16 * 16384; e += NGT) { const int hd = e >> 14, idx = e & 16383, dk = idx >> 7; float sacc = 0.f;
                const float* up = UB + (size_t)hd * NTILE * 16384 + idx; const float* ap = AG + hd * NTILE * 128 + dk; float* sp = SS + (size_t)hd * NTILE * 16384 + idx;
#pragma unroll 4
                for (int gI = 0; gI < NTILE; ++gI) { sp[(size_t)gI * 16384] = sacc; if (gI < NTILE - 1) sacc = ap[gI * 128] * sacc + up[(size_t)gI * 16384]; } }
            { const float* hw = args.in[12] + l * 128; const float* OF = WSP(float, WS_OF); const float* OB = WSP(float, WS_OB); const bf16* HBc = WSP(bf16, WS_HB); bf16* MIX = WSP(bf16, WS_MIX);
            for (int m = gw; m < LCTX; m += NGW) {
#pragma unroll
                for (int p = 0; p < 4; ++p) { const int col = p * 256 + lane * 4; const int dv = (lane & 31) * 4;
                    const f32x4 a = *(const f32x4*)(OF + (size_t)m * HGW + col), b = *(const f32x4*)(OB + (size_t)m * HGW + col); const f32x4 o = a + b;
                    float sq = (o[0] * o[0] + o[1] * o[1]) + (o[2] * o[2] + o[3] * o[3]);
#pragma unroll
                    for (int sh = 1; sh < 32; sh <<= 1) sq += __shfl_xor(sq, sh);
                    const float rstd = rsqrtf(sq * (1.f / 128.f) + EPS);
                    const v2u gb = *(const v2u*)(HBc + (size_t)m * 3072 + 2048 + col);
                    const f32x4 wv = *(const f32x4*)(hw + dv), gt4 = {__uint_as_float(gb.x << 16), __uint_as_float(gb.x & 0xffff0000u), __uint_as_float(gb.y << 16), __uint_as_float(gb.y & 0xffff0000u)};
                    f32x4 y = o * rstd * wv; y = (f32x4){y[0] * silu(gt4[0]), y[1] * silu(gt4[1]), y[2] * silu(gt4[2]), y[3] * silu(gt4[3])};
                    v2u w2; w2.x = pk2(y[0], y[1]); w2.y = pk2(y[2], y[3]); *(v2u*)(MIX + (size_t)m * DM + 1024 + col) = w2; } } }
            GRID_BAR();
        }
        if (IN(PH_HG3)) {
            PHASE_BEGIN();
            for (int u = vcu; u < 8 * 32; u += G) { const int h = u >> 5, T = 1 + (u & 31);
                hg_unit<1>(lds, WSP(float, WS_PH), WSP(float, WS_LB) + (0 * 4 + l) * 1024, nullptr, nullptr, WSP(float, WS_SS), WSP(float, WS_OF), h, 0, T, WSP(bf16, WS_HB));
                hg_unit<3>(lds, WSP(float, WS_PH), WSP(float, WS_LB) + (1 * 4 + l) * 1024, nullptr, nullptr, WSP(float, WS_SS), nullptr, h, 1, T, WSP(bf16, WS_HB), WSP(float, WS_OF), WSP(bf16, WS_MIX), args.in[12] + l * 128); }
            GRID_BAR();
        }
        if (IN(PH_OUTPROJ)) {
            PHASE_BEGIN();
            const float* modl = WSP(float, WS_MOD) + (size_t)(l * 2 + 0) * 12288;
            pg8::Gemm g{WSP(bf16, WS_MIX), WSP(bf16, WS_WOUT) + (size_t)l * DM * DM, MROWS, DM, DM}; pg8::ResidOrder S; S.init(DM, G, bx, l < NLAYER - 1, NSPLIT_O);
            pg8::EpiResid E{WSP(float, WS_X), l == 0 ? args.in[0] - (size_t)LCTX * DM : WSP(float, WS_X), modl + 2 * DM, WSP(float, WS_PARTO)};
            pg8::gemm_phase<pg8::EpiResid, pg8::ResidOrder>(lds, lds + LDSX_OFF, g, S, E);
            GRID_BAR();
        }
        if (IN(PH_NORM2)) {
            PHASE_BEGIN();
            const float* modl = WSP(float, WS_MOD) + (size_t)(l * 2 + 0) * 12288; const float* modc = modl + 12288; float* X = WSP(float, WS_X); bf16* H = WSP(bf16, WS_H); const float* nw = args.in[7] + l * DM;
            const float* parto = WSP(float, WS_PARTO);
            if (l < NLAYER - 1) for (int m = vcu; m < LCTX; m += G)
                norm_mod_row_wg(l == 0 ? args.in[2] + (size_t)m * DM : X + (size_t)m * DM, X + (size_t)m * DM, nw, modc + 3 * DM, modc + 4 * DM, H + (size_t)m * DM, lane, wave, (LAS float*)lds, parto + (size_t)m * DM, NSPLIT_O, modc + 2 * DM);
            for (int m = LCTX + gw; m < MROWS; m += NGW)
                norm_mod_row(X + (size_t)m * DM, X + (size_t)m * DM, nw, modl + 3 * DM, modl + 4 * DM, H + (size_t)m * DM, lane, nullptr, 0, nullptr);
            GRID_BAR();
        }
        if (IN(PH_UP)) {
            PHASE_BEGIN();
            pg8::Gemm g{WSP(bf16, WS_H), WSP(bf16, WS_WUP) + (size_t)l * FF2 * DM, MROWS, FF2, DM}; pg8::StaticOrder S;
            if (l < NLAYER - 1) S.init(MROWS, FF2, DM, G, bx); else S.init(SEQ, FF2, DM, G, bx, 1);
            pg8::EpiUpConv E{WSP(bf16, WS_ACT), WSP(float, WS_HALO), args.in[15] + (size_t)l * 3 * FF, args.in[16] + (size_t)l * FF};
            pg8::gemm_phase<pg8::EpiUpConv, pg8::StaticOrder>(lds, lds + LDSX_OFF, g, S, E);
            GRID_BAR();
        }
        if (IN(PH_CONV)) {
            PHASE_BEGIN();
            const float* cw = args.in[15] + (size_t)l * 3 * FF; const float* cb = args.in[16] + (size_t)l * FF; const float* HALO = WSP(float, WS_HALO); bf16* ACT = WSP(bf16, WS_ACT);
            for (int i = gt; i < 31 * 2 * (FF / 4); i += NGT) { const int c = (i % (FF / 4)) * 4, rb = i / (FF / 4), b = 1 + (rb >> 1), second = rb & 1;
                const float* ha = HALO + (size_t)b * 6 * FF + c; const float* hn = HALO + (size_t)(b + 1) * 6 * FF + c;
                const f32x4 w0 = *(const f32x4*)(cw + c), w1 = *(const f32x4*)(cw + FF + c), w2 = *(const f32x4*)(cw + 2 * FF + c), bb = *(const f32x4*)(cb + c);
                f32x4 gp, gc, gn, up; int row;
                if (!second) { gp = *(const f32x4*)(ha + 2 * FF); gc = *(const f32x4*)(ha + 3 * FF); gn = *(const f32x4*)(hn); up = *(const f32x4*)(ha + 5 * FF); row = 256 * b + 255; }
                else         { gp = *(const f32x4*)(ha + 3 * FF); gc = *(const f32x4*)(hn); gn = *(const f32x4*)(hn + FF); up = *(const f32x4*)(hn + 4 * FF); row = 256 * (b + 1); }
                const f32x4 z = gp * w0 + gc * w1 + gn * w2 + bb;
                v2u o; o.x = pk2(silu(z[0]) * up[0], silu(z[1]) * up[1]); o.y = pk2(silu(z[2]) * up[2], silu(z[3]) * up[3]);
                *(v2u*)(ACT + (size_t)row * FF + c) = o; }
            GRID_BAR();
        }
        if (IN(PH_DOWN)) {
            PHASE_BEGIN();
            const float* modl = WSP(float, WS_MOD) + (size_t)(l * 2 + 0) * 12288;
            pg8::Gemm g{WSP(bf16, WS_ACT), WSP(bf16, WS_WDN) + (size_t)l * DM * FF, MROWS, DM, FF}; pg8::ResidOrder S; S.init(FF, G, bx, l < NLAYER - 1, NSPLIT_D);
            pg8::EpiResid E{WSP(float, WS_X), WSP(float, WS_X), modl + 5 * DM, WSP(float, WS_PARTD)};
            pg8::gemm_phase<pg8::EpiResid, pg8::ResidOrder>(lds, lds + LDSX_OFF, g, S, E);
            GRID_BAR();
        }
    }
    if (IN(PH_FINAL)) {
        PHASE_BEGIN();
        const float* X = WSP(float, WS_X); const float* fw = args.in[18];
        for (int m = gw; m < SEQ; m += NGW) { const f32x4* xr = (const f32x4*)(X + (size_t)(LCTX + m) * DM) + lane; f32x4 v[8]; float sq = 0.f;
#pragma unroll
            for (int j = 0; j < 8; ++j) { v[j] = xr[64 * j]; sq += (v[j][0] * v[j][0] + v[j][1] * v[j][1]) + (v[j][2] * v[j][2] + v[j][3] * v[j][3]); }
            const float rstd = rsqrtf(wave_sum(sq) * (1.f / DM) + EPS);
            f32x4* o = (f32x4*)(args.out + (size_t)m * DM) + lane;
#pragma unroll
            for (int j = 0; j < 8; ++j) o[64 * j] = v[j] * rstd * ((const f32x4*)fw)[lane + 64 * j]; }
    }
#undef IN
#undef GRID_BAR
#undef PHASE_BEGIN
#undef WSP
}

extern "C" void kernel_launch(void* const* d_in, const int* in_sizes, int n_in, void* d_out, int out_size, void* d_ws, size_t ws_size, hipStream_t stream) {
    static int grid = 0;
    if (grid == 0) {
        if (n_in != 19 || in_sizes[0] != SEQ * DM || out_size != SEQ * DM || ws_size < WS_END) {
            fprintf(stderr, "kernel_launch: unexpected shapes: n_in %d in0 %d out %d ws %zu (need %zu)\n", n_in, n_in > 0 ? in_sizes[0] : -1, out_size, ws_size, (size_t)WS_END); grid = -1; return; }
        int dev = 0, cus = 0;
        if (hipGetDevice(&dev) != hipSuccess || hipDeviceGetAttribute(&cus, hipDeviceAttributeMultiprocessorCount, dev) != hipSuccess) { grid = -1; return; }
        if (hipFuncSetAttribute((const void*)fwd_kernel, hipFuncAttributeMaxDynamicSharedMemorySize, LDS_BYTES) != hipSuccess) { fprintf(stderr, "kernel_launch: hipFuncSetAttribute failed\n"); grid = -1; return; }
        int per_cu = 0;
        if (hipOccupancyMaxActiveBlocksPerMultiprocessor(&per_cu, (const void*)fwd_kernel, NWAVES * 64, LDS_BYTES) != hipSuccess || per_cu < 1) fprintf(stderr, "kernel_launch: occupancy query says %d\n", per_cu);
        (void)hipGetLastError();
        grid = cus;
    }
    if (grid < 0) return;
    (void)hipMemsetAsync((char*)d_ws + WS_CTL, 0, CTL_ZERO_BYTES, stream);
    Args a{};
    for (int i = 0; i < 19; ++i) a.in[i] = (const float*)d_in[i];
    a.out = (float*)d_out; a.ws = (unsigned char*)d_ws;
#if MK_ONE_LAUNCH
    a.ph_lo = 0; a.ph_hi = PH_COUNT; a.l_lo = 0; a.l_hi = NLAYER; a.use_bar = 1;
    hipLaunchKernelGGL(fwd_kernel, dim3(grid), dim3(NWAVES * 64), LDS_BYTES, stream, a);
#else
    a.use_bar = 0;
    a.ph_lo = PH_PRO; a.ph_hi = PH_PRO + 1; a.l_lo = 0; a.l_hi = 0;
    hipLaunchKernelGGL(fwd_kernel, dim3(grid), dim3(NWAVES * 64), LDS_BYTES, stream, a);
    for (int l = 0; l < NLAYER; ++l)
        for (int p = PH_NORM1; p <= PH_DOWN; ++p) { a.ph_lo = p; a.ph_hi = p + 1; a.l_lo = l; a.l_hi = l + 1;
            hipLaunchKernelGGL(fwd_kernel, dim3(grid), dim3(NWAVES * 64), LDS_BYTES, stream, a); }
    a.ph_lo = PH_FINAL; a.ph_hi = PH_FINAL + 1; a.l_lo = 0; a.l_hi = 0;
    hipLaunchKernelGGL(fwd_kernel, dim3(grid), dim3(NWAVES * 64), LDS_BYTES, stream, a);
#endif
    const hipError_t le = hipPeekAtLastError();
    if (le != hipSuccess) fprintf(stderr, "kernel_launch: launch failed: %s\n", hipGetErrorName(le));
}
```
